# Optimizing an MI355X kernel written in HIP

```python
import jax, jax.numpy as jnp
from jax import lax
import numpy as np

D_MODEL = 1024
BATCH = 4
SEQ = 4096
DEPTH = 2

CHUNK = 64
Q_BLOCK = 128
HEAD_DIM = 64
SB_WIDTH = 3 * D_MODEL // 8
SB_HEADS = SB_WIDTH // HEAD_DIM
RW_WIDTH = 3 * D_MODEL // 8
RW_HEADS = RW_WIDTH // HEAD_DIM
RW_DECAY_RANK = 32
RW_A_RANK = 32
RW_GATE_RANK = 64
RW_GN_EPS = 64e-5
RW_SPLIT = (RW_WIDTH, RW_WIDTH, RW_WIDTH, RW_DECAY_RANK, RW_A_RANK, RW_GATE_RANK)
RW_IN_WIDTH = sum(RW_SPLIT)
GLA_VAL_WIDTH = D_MODEL // 4
GLA_KEY_WIDTH = GLA_VAL_WIDTH // 2
GLA_DV = 64
GLA_HEADS = GLA_VAL_WIDTH // GLA_DV
GLA_DK = GLA_KEY_WIDTH // GLA_HEADS
GLA_GATE_RANK = 16
GLA_GATE_NORMALIZER = 16.0
GLA_SPLIT = (GLA_KEY_WIDTH, GLA_KEY_WIDTH, GLA_VAL_WIDTH, GLA_GATE_RANK, GLA_VAL_WIDTH)
GLA_IN_WIDTH = sum(GLA_SPLIT)

MIX_WIDTH = SB_WIDTH + RW_WIDTH + GLA_VAL_WIDTH
IN_WIDTH = 3 * SB_WIDTH + RW_IN_WIDTH + GLA_IN_WIDTH
D_FF = 4 * D_MODEL
EPS = 1e-6

kernel_name = 'hybrid_sb_rwkv7_gla_block'


def split_sizes(t, sizes):
    idx = [int(i) for i in np.cumsum(sizes)[:-1]]
    return jnp.split(t, idx, axis=-1)


def rmsnorm(x, gain):
    xf = x.astype(jnp.float32)
    y = xf * lax.rsqrt(jnp.mean(xf * xf, axis=-1, keepdims=True) + EPS)
    return (y * gain.astype(jnp.float32)).astype(x.dtype)


def head_rmsnorm(o, gain, n_heads):
    B, T, C = o.shape
    oh = o.reshape(B, T, n_heads, C // n_heads)
    return rmsnorm(oh, gain.reshape(n_heads, C // n_heads)).reshape(B, T, C)


def token_shift(p, mu):
    prev = jnp.pad(p, ((0, 0), (1, 0), (0, 0)))[:, :-1]
    return p + (prev - p) * mu


def stick_breaking_attention(q, k, v):
    B, T, C = q.shape
    H = SB_HEADS
    Dh = C // H
    n_blk = T // Q_BLOCK
    qh = q.reshape(B, n_blk, Q_BLOCK, H, Dh).transpose(1, 0, 2, 3, 4)
    kh = k.reshape(B, T, H, Dh)
    vh = v.reshape(B, T, H, Dh)
    key_pos = jnp.arange(T)
    scale = Dh ** -0.5

    def block(args):
        q_blk, blk = args
        z = jnp.einsum('bqhd,bkhd->bhqk', q_blk, kh).astype(jnp.float32) * scale
        q_pos = blk * Q_BLOCK + jnp.arange(Q_BLOCK)
        mask = key_pos[None, :] < q_pos[:, None]
        log_1m_beta = jnp.where(mask, jax.nn.log_sigmoid(-z), 0.0)
        between = lax.cumsum(log_1m_beta, axis=3, reverse=True) - log_1m_beta
        weights = jnp.where(mask, jnp.exp(jax.nn.log_sigmoid(z) + between), 0.0)
        return jnp.einsum('bhqk,bkhd->bqhd', weights.astype(vh.dtype), vh)

    out = lax.map(block, (qh, jnp.arange(n_blk)))
    return out.transpose(1, 0, 2, 3, 4).reshape(B, T, C)


def rwkv7_time_mix(rw_in, mu, w0, w_up, a0, a_up, g_up, k_k, k_a, r_k, gn_g, gn_b):
    B, T, _ = rw_in.shape
    H, N = RW_HEADS, HEAD_DIM
    f32 = jnp.float32
    r, k, v, wd, ad, gd = split_sizes(token_shift(rw_in, mu), RW_SPLIT)
    log_w = -jax.nn.softplus(-(w0 + jnp.tanh(wd) @ w_up).astype(f32)) - 0.5
    decay = jnp.exp(-jnp.exp(log_w))
    a = jax.nn.sigmoid((a0 + ad @ a_up).astype(f32))
    g = jax.nn.sigmoid(gd) @ g_up

    def heads(t):
        return t.astype(f32).reshape(B, T, H, N)

    kk = heads(k * k_k)
    kk = kk * lax.rsqrt(jnp.maximum(jnp.sum(kk * kk, axis=-1, keepdims=True), 1e-12))
    k_mod = k.astype(f32) * (1.0 + (a - 1.0) * k_a)
    rh, kh, vh, wh, ah = heads(r), heads(k_mod), heads(v), heads(decay), heads(a)
    a_vec = -kk
    b_vec = kk * ah

    def step(S, inp):
        r_t, w_t, k_t, v_t, a_t, b_t = inp
        sa = jnp.einsum('bhvk,bhk->bhv', S, a_t)
        S = S * w_t[:, :, None, :] + sa[..., None] * b_t[:, :, None, :] + v_t[..., None] * k_t[:, :, None, :]
        return S, jnp.einsum('bhvk,bhk->bhv', S, r_t)

    xs = tuple(t.transpose(1, 0, 2, 3) for t in (rh, wh, kh, vh, a_vec, b_vec))
    S0 = jnp.zeros((B, H, N, N), f32)
    _, y = lax.scan(step, S0, xs)
    y = y.transpose(1, 0, 2, 3)
    mean = jnp.mean(y, axis=-1, keepdims=True)
    var = jnp.mean(jnp.square(y - mean), axis=-1, keepdims=True)
    yn = (y - mean) * lax.rsqrt(var + RW_GN_EPS) * gn_g.astype(f32).reshape(H, N) + gn_b.astype(f32).reshape(H, N)
    bonus = jnp.sum(rh * kh * r_k.astype(f32).reshape(H, N), axis=-1, keepdims=True) * vh
    out = (yn + bonus).reshape(B, T, H * N) * g.astype(f32)
    return out.astype(rw_in.dtype)


def gla_linear_attention(q, k, v, gd, g, gate_up, gate_b, norm_g):
    B, T, _ = q.shape
    H, DK, DV, C = GLA_HEADS, GLA_DK, GLA_DV, CHUNK
    nc = T // C
    f32 = jnp.float32
    log_alpha = jax.nn.log_sigmoid((gd @ gate_up + gate_b).astype(f32)) / GLA_GATE_NORMALIZER

    def chunks(t, d):
        return t.astype(f32).reshape(B, nc, C, H, d).transpose(1, 0, 3, 2, 4)

    qc = chunks(q, DK) * (DK ** -0.5)
    kc, vc, lc = chunks(k, DK), chunks(v, DV), chunks(log_alpha, DK)
    causal = jnp.tril(jnp.ones((C, C), dtype=bool))

    def step(S, inp):
        q_c, k_c, v_c, la_c = inp
        b = jnp.cumsum(la_c, axis=2)
        o_inter = jnp.einsum('bhtk,bhkv->bhtv', q_c * jnp.exp(b), S)
        diff = b[:, :, :, None, :] - b[:, :, None, :, :]
        decay = jnp.exp(jnp.where(causal[:, :, None], diff, -jnp.inf))
        scores = jnp.einsum('bhtk,bhsk,bhtsk->bhts', q_c, k_c, decay)
        o_intra = jnp.einsum('bhts,bhsv->bhtv', scores, v_c)
        b_last = b[:, :, -1:, :]
        S = S * jnp.exp(b_last)[:, :, 0, :, None] + jnp.einsum('bhsk,bhsv->bhkv', k_c * jnp.exp(b_last - b), v_c)
        return S, o_inter + o_intra

    S0 = jnp.zeros((B, H, DK, DV), f32)
    _, o = lax.scan(step, S0, (qc, kc, vc, lc))
    o = o.transpose(1, 0, 3, 2, 4).reshape(B, T, H * DV)
    o = head_rmsnorm(o, norm_g, H) * jax.nn.silu(g.astype(f32))
    return o.astype(q.dtype)


def setup_inputs(seed: int = 0) -> dict:
    key = jax.random.key(seed)
    ks = jax.random.split(key, 26)
    f32 = jnp.float32
    L = DEPTH

    def nrm(k, shape, scale):
        return jax.random.normal(k, shape, f32) * scale

    def gain(k, shape):
        return 1.0 + 0.05 * jax.random.normal(k, shape, f32)

    return {
        'x': nrm(ks[0], (BATCH, SEQ, D_MODEL), 1.0),
        'pre_mix_g': gain(ks[1], (L, D_MODEL)),
        'w_in': nrm(ks[2], (L, D_MODEL, IN_WIDTH), D_MODEL ** -0.5),
        'sb_norm_g': gain(ks[3], (L, SB_WIDTH)),
        'rw_mu': jax.random.uniform(ks[4], (L, RW_IN_WIDTH), f32, 0.2, 0.8),
        'rw_w0': jax.random.uniform(ks[5], (L, RW_WIDTH), f32, -5.0, 1.0),
        'rw_w_up': nrm(ks[6], (L, RW_DECAY_RANK, RW_WIDTH), 0.5 * RW_DECAY_RANK ** -0.5),
        'rw_a0': nrm(ks[7], (L, RW_WIDTH), 0.1),
        'rw_a_up': nrm(ks[8], (L, RW_A_RANK, RW_WIDTH), 0.5 * RW_A_RANK ** -0.5),
        'rw_g_up': nrm(ks[9], (L, RW_GATE_RANK, RW_WIDTH), RW_GATE_RANK ** -0.5),
        'rw_k_k': 0.85 + 0.05 * jax.random.normal(ks[10], (L, RW_WIDTH), f32),
        'rw_k_a': gain(ks[11], (L, RW_WIDTH)),
        'rw_r_k': nrm(ks[12], (L, RW_WIDTH), 0.1),
        'rw_gn_g': gain(ks[13], (L, RW_WIDTH)),
        'rw_gn_b': nrm(ks[14], (L, RW_WIDTH), 0.01),
        'gla_gate_up': nrm(ks[15], (L, GLA_GATE_RANK, GLA_KEY_WIDTH), GLA_GATE_RANK ** -0.5),
        'gla_gate_b': nrm(ks[16], (L, GLA_KEY_WIDTH), 0.5),
        'gla_norm_g': gain(ks[17], (L, GLA_VAL_WIDTH)),
        'w_out': nrm(ks[18], (L, MIX_WIDTH, D_MODEL), MIX_WIDTH ** -0.5),
        'post_mix_g': gain(ks[19], (L, D_MODEL)),
        'pre_ffn_g': gain(ks[20], (L, D_MODEL)),
        'w_ff1': nrm(ks[21], (L, D_MODEL, D_FF), D_MODEL ** -0.5),
        'w_ff2': nrm(ks[22], (L, D_FF, D_MODEL), D_FF ** -0.5),
        'post_ffn_g': gain(ks[23], (L, D_MODEL)),
    }


def reference(x, pre_mix_g, w_in, sb_norm_g, rw_mu, rw_w0, rw_w_up, rw_a0, rw_a_up, rw_g_up,
              rw_k_k, rw_k_a, rw_r_k, rw_gn_g, rw_gn_b, gla_gate_up, gla_gate_b, gla_norm_g,
              w_out, post_mix_g, pre_ffn_g, w_ff1, w_ff2, post_ffn_g):
    for l in range(DEPTH):
        h = rmsnorm(x, pre_mix_g[l])
        proj = h @ w_in[l]
        sb_in, rw_in, gla_in = split_sizes(proj, (3 * SB_WIDTH, RW_IN_WIDTH, GLA_IN_WIDTH))
        sb_q, sb_k, sb_v = split_sizes(sb_in, (SB_WIDTH, SB_WIDTH, SB_WIDTH))
        o_sb = head_rmsnorm(stick_breaking_attention(sb_q, sb_k, sb_v), sb_norm_g[l], SB_HEADS)
        o_rw = rwkv7_time_mix(rw_in, rw_mu[l], rw_w0[l], rw_w_up[l], rw_a0[l], rw_a_up[l], rw_g_up[l],
                              rw_k_k[l], rw_k_a[l], rw_r_k[l], rw_gn_g[l], rw_gn_b[l])
        g_q, g_k, g_v, g_gd, g_g = split_sizes(gla_in, GLA_SPLIT)
        o_gla = gla_linear_attention(g_q, g_k, g_v, g_gd, g_g, gla_gate_up[l], gla_gate_b[l], gla_norm_g[l])
        mixed = jnp.concatenate([o_sb, o_rw, o_gla], axis=-1) @ w_out[l]
        x = x + rmsnorm(mixed, post_mix_g[l])
        h = rmsnorm(x, pre_ffn_g[l])
        ff = jnp.square(jax.nn.relu(h @ w_ff1[l])) @ w_ff2[l]
        x = x + rmsnorm(ff, post_ffn_g[l])
    return x
```

```cpp
#include <hip/hip_runtime.h>
#include <hip/hip_cooperative_groups.h>
#include <cstdio>
#include <cstdint>
namespace cg = cooperative_groups;

typedef unsigned short u16;
typedef unsigned int u32;
using bf16x8 = __attribute__((ext_vector_type(8))) short;
using f32x4 = __attribute__((ext_vector_type(4))) float;

#ifndef REPEAT_MASK
#define REPEAT_MASK 0
#endif
#ifndef MULTI_LAUNCH
#define MULTI_LAUNCH 0
#endif

constexpr int NT = 512;
constexpr int Bsz = 4, T = 4096, D = 1024, M = Bsz * T;
constexpr int INW = 3216, INP = 3328;
constexpr int DFF = 4096;
constexpr int SBQ = 0, SBK = 384, SBV = 768;
constexpr int RW0 = 1152;
constexpr int GL0 = 2432;
constexpr float EPS = 1e-6f;
constexpr float LOG2E = 1.4426950408889634f;

constexpr size_t WS_CTRL = 0;
constexpr size_t WS_WIN = 1u << 20;
constexpr size_t WS_WOUT = WS_WIN + (size_t)INP * D * 2;
constexpr size_t WS_WF1 = WS_WOUT + (size_t)D * D * 2;
constexpr size_t WS_WF2 = WS_WF1 + (size_t)DFF * D * 2;
constexpr size_t WS_ABUF = WS_WF2 + (size_t)DFF * D * 2;
constexpr size_t WS_BIG = WS_ABUF + (size_t)M * D * 2;
constexpr size_t WS_PROJ = WS_BIG;
constexpr size_t WS_RWP = WS_PROJ + (size_t)M * INW * 2;
constexpr size_t WS_VY = WS_RWP + (size_t)M * 384 * 12;
constexpr size_t WS_GLAS = WS_VY + (size_t)M * 384 * 2;
constexpr size_t WS_GLAD = WS_GLAS + (size_t)1024 * 2048 * 4;
constexpr size_t WS_MIX_END = WS_GLAD + (size_t)1024 * 32 * 4;
constexpr size_t WS_CBUF = WS_BIG;
constexpr size_t WS_FFH = WS_CBUF + (size_t)M * D * 4;
constexpr size_t WS_FFN_END = WS_FFH + (size_t)M * DFF * 2;
static_assert(WS_MIX_END <= (256u << 20) && WS_FFN_END <= (256u << 20), "workspace");

struct Params {
  const float* in[24];
  float* out;
  unsigned char* ws;
  int phase_lo, phase_hi;
};

__device__ __forceinline__ u16 f2bf(float f) {
  u32 u = __float_as_uint(f);
  u += 0x7fffu + ((u >> 16) & 1u);
  return (u16)(u >> 16);
}
__device__ __forceinline__ float bf2f(u16 h) { return __uint_as_float(((u32)h) << 16); }
__device__ __forceinline__ u32 pack2(float lo, float hi) { return (u32)f2bf(lo) | ((u32)f2bf(hi) << 16); }
__device__ __forceinline__ float wsum_shfl(float v) {
#pragma unroll
  for (int o = 32; o > 0; o >>= 1) v += __shfl_xor(v, o, 64);
  return v;
}
template <int CTRL>
__device__ __forceinline__ float dppx(float x) {
  return __builtin_bit_cast(float, __builtin_amdgcn_mov_dpp(__builtin_bit_cast(int, x), CTRL, 0xf, 0xf, true));
}
__device__ __forceinline__ float wsum_dpp63(float v) {
  v += dppx<0xB1>(v);
  v += dppx<0x4E>(v);
  v += dppx<0x141>(v);
  v += dppx<0x128>(v);
  v += dppx<0x142>(v);
  v += dppx<0x143>(v);
  return v;
}
__device__ __forceinline__ float rdlane63(float v);
__device__ __forceinline__ float wsum_u(float v) { return rdlane63(wsum_dpp63(v)); }
__device__ __forceinline__ float rdlane63(float v) {
  return __builtin_bit_cast(float, __builtin_amdgcn_readlane(__builtin_bit_cast(int, v), 63));
}
__device__ __forceinline__ void lds_barrier() { asm volatile("s_waitcnt lgkmcnt(0)\n\ts_barrier" ::: "memory"); }
__device__ __forceinline__ void glds16(const void* g, unsigned lds_base) {
  unsigned sv;
  asm volatile("s_mov_b32 %0, m0\n\ts_mov_b32 m0, %2\n\ts_nop 0\n\tglobal_load_lds_dwordx4 %1, off\n\ts_mov_b32 m0, %0"
               : "=&s"(sv) : "v"(g), "s"(lds_base) : "memory");
}
__device__ __forceinline__ int opaque_tid() { int t = threadIdx.x; asm volatile("" : "+v"(t)); return t; }
__device__ __forceinline__ float softplus_f(float x) {
  return fmaxf(x, 0.f) + __logf(1.f + __expf(-fabsf(x)));
}

__device__ void prep_weight(const float* __restrict__ W, const float* __restrict__ gain, u16* __restrict__ Wt,
                            int K, int N, int Npad, float* lds, int bid, int G) {
  const int tid = opaque_tid();
  const int tk_n = K / 64, tn_n = Npad / 64;
  for (int tile = bid; tile < tk_n * tn_n; tile += G) {
    const int tk = tile % tk_n, tn = tile / tk_n;
    const int k0 = tk * 64, n0 = tn * 64;
    const int j = tid & 63, i0 = tid >> 6;
#pragma unroll
    for (int r = 0; r < 8; ++r) {
      const int i = i0 + 8 * r;
      const int n = n0 + j;
      float v = 0.f;
      if (n < N) { v = W[(size_t)(k0 + i) * N + n]; if (gain) v *= gain[k0 + i]; }
      lds[i * 65 + j] = v;
    }
    __syncthreads();
#pragma unroll
    for (int r = 0; r < 4; ++r) {
      const int jn = (tid >> 5) + 16 * r;
      const int ik = (tid & 31) * 2;
      *(u32*)(Wt + (size_t)(n0 + jn) * K + k0 + ik) = pack2(lds[ik * 65 + jn], lds[(ik + 1) * 65 + jn]);
    }
    __syncthreads();
  }
}

__device__ void prep_weights_layer(const Params& p, int l, float* lds, int G) {
  unsigned char* ws = p.ws;
  prep_weight(p.in[2] + (size_t)l * D * INW, p.in[1] + l * D, (u16*)(ws + WS_WIN), D, INW, INP, lds, blockIdx.x, G);
  prep_weight(p.in[18] + (size_t)l * D * D, nullptr, (u16*)(ws + WS_WOUT), D, D, D, lds, blockIdx.x, G);
  prep_weight(p.in[21] + (size_t)l * D * DFF, p.in[20] + l * D, (u16*)(ws + WS_WF1), D, DFF, DFF, lds, blockIdx.x, G);
  prep_weight(p.in[22] + (size_t)l * DFF * D, nullptr, (u16*)(ws + WS_WF2), DFF, D, D, lds, blockIdx.x, G);
}

__device__ void row_phase(const float* __restrict__ xold, const u16* __restrict__ y, const float* __restrict__ gain,
                          float* __restrict__ xnew, u16* __restrict__ hn, int G) {
  const int tid = opaque_tid(); const int lane = tid & 63, wave = tid >> 6;
  for (int row = blockIdx.x * 8 + wave; row < M; row += G * 8) {
    float4 xv[4];
#pragma unroll
    for (int j = 0; j < 4; ++j) xv[j] = *(const float4*)(xold + (size_t)row * D + j * 256 + lane * 4);
    if (y) {
      float4 yv[4];
      float ss = 0.f;
#pragma unroll
      for (int j = 0; j < 4; ++j) {
        const uint2 yr = *(const uint2*)(y + (size_t)row * D + j * 256 + lane * 4);
        yv[j].x = __uint_as_float(yr.x << 16); yv[j].y = __uint_as_float(yr.x & 0xffff0000u);
        yv[j].z = __uint_as_float(yr.y << 16); yv[j].w = __uint_as_float(yr.y & 0xffff0000u);
        ss += yv[j].x * yv[j].x + yv[j].y * yv[j].y + yv[j].z * yv[j].z + yv[j].w * yv[j].w;
      }
      ss = wsum_shfl(ss);
      const float rs = rsqrtf(ss * (1.f / D) + EPS);
#pragma unroll
      for (int j = 0; j < 4; ++j) {
        const float4 g = *(const float4*)(gain + j * 256 + lane * 4);
        xv[j].x += yv[j].x * rs * g.x; xv[j].y += yv[j].y * rs * g.y;
        xv[j].z += yv[j].z * rs * g.z; xv[j].w += yv[j].w * rs * g.w;
      }
    }
    if (xnew) {
#pragma unroll
      for (int j = 0; j < 4; ++j) *(float4*)(xnew + (size_t)row * D + j * 256 + lane * 4) = xv[j];
    }
    if (hn) {
      float ss = 0.f;
#pragma unroll
      for (int j = 0; j < 4; ++j) ss += xv[j].x * xv[j].x + xv[j].y * xv[j].y + xv[j].z * xv[j].z + xv[j].w * xv[j].w;
      ss = wsum_shfl(ss);
      const float rs = rsqrtf(ss * (1.f / D) + EPS);
#pragma unroll
      for (int j = 0; j < 4; ++j) {
        uint2 o;
        o.x = pack2(xv[j].x * rs, xv[j].y * rs);
        o.y = pack2(xv[j].z * rs, xv[j].w * rs);
        *(uint2*)(hn + (size_t)row * D + j * 256 + lane * 4) = o;
      }
    }
  }
}

constexpr int EPI_BF16 = 0, EPI_RELU2 = 1, EPI_F32 = 2;
constexpr int GBM = 256, GBN = 128, GBK = 64, GLD = 64;
template <int EPI>
__device__ void gemm_phase(const u16* __restrict__ A, const u16* __restrict__ Bt, void* __restrict__ Cv,
                           int N, int K, int ldc, unsigned char* ldsraw, int G) {
  u16* As = (u16*)ldsraw;
  u16* Bs = As + 2 * GBM * GLD;
  const int tid = opaque_tid(), lane = tid & 63, wave = tid >> 6;
  const int wm = wave >> 1, wn = wave & 1;
  const int l15 = lane & 15, g4 = lane >> 4;
  const int ntn = (N + GBN - 1) / GBN, ntm = M / GBM;
  const int nk = K / GBK;
  const bool swz = (G == 256) && (ntn != 32);
  const int t_begin = swz ? (int)(blockIdx.x >> 3) : (int)blockIdx.x;
  const int t_step = swz ? 32 : G;
  const int t_end = swz ? (ntm / 8) * ntn : ntm * ntn;
  for (int tile = t_begin; tile < t_end; tile += t_step) {
    int tn = tile % ntn, tm = tile / ntn;
    if (swz) tm = (blockIdx.x & 7) + 8 * tm;
    const int m0 = tm * GBM, n0 = tn * GBN;
    f32x4 acc[4][4];
#pragma unroll
    for (int i = 0; i < 4; ++i)
#pragma unroll
      for (int j = 0; j < 4; ++j) acc[i][j] = (f32x4){0.f, 0.f, 0.f, 0.f};
    const int ar0 = tid >> 3, acc4 = tid & 7;
    const int ssw = (acc4 ^ ((ar0 >> 1) & 7)) * 8;
    const int fx = (l15 >> 1) & 7;
    const u16* Ag0 = A + (size_t)(m0 + ar0) * K + ssw;
    const u16* Bg = Bt + (size_t)(n0 + ar0) * K + ssw;
    const size_t r64 = (size_t)64 * K;
    constexpr int STG = (GBM + GBN) * GLD;
    const unsigned lw0 = (unsigned)__builtin_amdgcn_readfirstlane((int)(unsigned)(uintptr_t)(As + wave * 8 * GLD));
#define GLDS(st_, kt_) { const int kk_ = ((kt_) < nk ? (kt_) : nk - 1) * GBK; const unsigned d_ = lw0 + (unsigned)(st_) * (STG * 2); \
      glds16(Ag0 + kk_, d_); glds16(Ag0 + r64 + kk_, d_ + 64 * GLD * 2); glds16(Ag0 + 2 * r64 + kk_, d_ + 128 * GLD * 2); glds16(Ag0 + 3 * r64 + kk_, d_ + 192 * GLD * 2); \
      glds16(Bg + kk_, d_ + GBM * GLD * 2); glds16(Bg + r64 + kk_, d_ + (GBM + 64) * GLD * 2); }
    GLDS(0, 0);
    GLDS(1, 1);
    if (__builtin_amdgcn_readfirstlane(tid) >= 256) __builtin_amdgcn_s_setprio(1);
    int st = 0;
    for (int kt = 0; kt < nk; ++kt) {
      asm volatile("s_waitcnt vmcnt(6)" ::: "memory");
      lds_barrier();
      const int st2 = (st >= 1) ? st - 1 : 2;
      GLDS(st2, kt + 2);
      const u16* Asx = As + st * STG;
      const u16* Bsx = Asx + GBM * GLD;
#pragma unroll
      for (int ks = 0; ks < 2; ++ks) {
        const int fsw = ((ks * 4 + g4) ^ fx) * 8;
        bf16x8 bfr[4];
#pragma unroll
        for (int jx = 0; jx < 4; ++jx) bfr[jx] = *(const bf16x8*)(Bsx + (wn * 64 + jx * 16 + l15) * GLD + fsw);
#pragma unroll
        for (int ix = 0; ix < 4; ++ix) {
          const bf16x8 af = *(const bf16x8*)(Asx + (wm * 64 + ix * 16 + l15) * GLD + fsw);
#pragma unroll
          for (int jx = 0; jx < 4; ++jx)
            acc[ix][jx] = __builtin_amdgcn_mfma_f32_16x16x32_bf16(af, bfr[jx], acc[ix][jx], 0, 0, 0);
        }
      }
      st = (st == 2) ? 0 : st + 1;
    }
    __builtin_amdgcn_s_setprio(0);
    asm volatile("s_waitcnt vmcnt(0)" ::: "memory");
    lds_barrier();
#undef GLDS
#pragma unroll
    for (int i = 0; i < 4; ++i) {
#pragma unroll
      for (int r = 0; r < 4; ++r) {
        const int m = m0 + wm * 64 + i * 16 + g4 * 4 + r;
        const int nb = n0 + wn * 64 + l15;
        if (EPI == EPI_F32) {
          float* cp = (float*)Cv + (size_t)m * ldc + nb;
#pragma unroll
          for (int j = 0; j < 4; ++j) if (nb + j * 16 < N) cp[j * 16] = acc[i][j][r];
        } else {
          u16* cp = (u16*)Cv + (size_t)m * ldc + nb;
#pragma unroll
          for (int j = 0; j < 4; ++j) {
            float v = acc[i][j][r];
            if (EPI == EPI_RELU2) { v = fmaxf(v, 0.f); v = v * v; }
            if (nb + j * 16 < N) cp[j * 16] = f2bf(v);
          }
        }
      }
      __builtin_amdgcn_sched_barrier(0);
    }
  }
}

__device__ void rwprep_items(const Params& p, int l, unsigned char* ldsraw, int it_begin, int it_end, int it_step) {
  float* codes = (float*)ldsraw;
  const u16* proj = (const u16*)(p.ws + WS_PROJ);
  u32* rwp = (u32*)(p.ws + WS_RWP);
  u16* vy = (u16*)(p.ws + WS_VY);
  const float* mu = p.in[4] + l * 1280;
  const float* w0 = p.in[5] + l * 384;
  const float* w_up = p.in[6] + l * 32 * 384;
  const float* a0 = p.in[7] + l * 384;
  const float* a_up = p.in[8] + l * 32 * 384;
  const float* k_k = p.in[10] + l * 384;
  const float* k_a = p.in[11] + l * 384;
  const float* r_k = p.in[12] + l * 384;
  float* bon = (float*)(p.ws + WS_CTRL + 65536);
  const int tid = opaque_tid();
  for (int it = it_begin; it < it_end; it += it_step) {
    const int tok0 = it * 4;
    if (tid < 256) {
      const int tt = tid >> 6, j = tid & 63;
      const int tok = tok0 + tt;
      const int col = 1152 + j;
      const float pc = bf2f(proj[(size_t)tok * INW + RW0 + col]);
      const float pp = (tok % T == 0) ? 0.f : bf2f(proj[(size_t)(tok - 1) * INW + RW0 + col]);
      float s = pc + (pp - pc) * mu[col];
      if (j < 32) { const float e2 = __expf(2.f * s); s = 1.f - 2.f / (e2 + 1.f); }
      codes[tt * 64 + j] = s;
    }
    __syncthreads();
    if (tid < 384) {
      const int c = tid;
      float aw[4], aa[4];
      float pr_[5], pk_[5], pv_[5];
#pragma unroll
      for (int tt = 0; tt < 4; ++tt) { aw[tt] = 0.f; aa[tt] = 0.f; }
#pragma unroll
      for (int tt = 0; tt < 5; ++tt) {
        const int tok = tok0 + tt - 1;
        const bool ok = (tt > 0) || (tok0 % T != 0);
        const u16* pq = proj + (size_t)(ok ? tok : tok0) * INW + RW0;
        pr_[tt] = ok ? bf2f(pq[c]) : 0.f; pk_[tt] = ok ? bf2f(pq[384 + c]) : 0.f; pv_[tt] = ok ? bf2f(pq[768 + c]) : 0.f;
      }
#pragma unroll 4
      for (int j = 0; j < 32; ++j) {
        const float wu = w_up[j * 384 + c], au = a_up[j * 384 + c];
#pragma unroll
        for (int tt = 0; tt < 4; ++tt) {
          aw[tt] += codes[tt * 64 + j] * wu;
          aa[tt] += codes[tt * 64 + 32 + j] * au;
        }
      }
      const float mur = mu[c], muk = mu[384 + c], muv = mu[768 + c];
      const float w0c = w0[c], a0c = a0[c], kkc = k_k[c], kac = k_a[c], rkc = r_k[c];
#pragma unroll
      for (int tt = 0; tt < 4; ++tt) {
        const int tok = tok0 + tt;
        float r = pr_[tt + 1], k = pk_[tt + 1], v = pv_[tt + 1];
        const float r1 = pr_[tt], k1 = pk_[tt], v1 = pv_[tt];
        r += (r1 - r) * mur; k += (k1 - k) * muk; v += (v1 - v) * muv;
        const float xw = w0c + aw[tt];
        const float lw = -softplus_f(-xw) - 0.5f;
        const float dec = __expf(-__expf(lw));
        const float xa = a0c + aa[tt];
        const float asig = 1.f / (1.f + __expf(-xa));
        const float kkr = k * kkc;
        const float ssum = wsum_u(kkr * kkr);
        const float kk = kkr * rsqrtf(fmaxf(ssum, 1e-12f));
        const float kmod = k * (1.f + (asig - 1.f) * kac);
        const size_t o = ((size_t)tok * 384 + c) * 3;
        rwp[o] = __float_as_uint(dec);
        rwp[o + 1] = pack2(kk, kk * asig);
        rwp[o + 2] = pack2(kmod, r);
        const float bsum = wsum_u(r * kmod * rkc);
        if ((tid & 63) == 0) bon[(size_t)tok * 6 + (tid >> 6)] = bsum;
        vy[(size_t)tok * 384 + c] = f2bf(v);
      }
    }
    __syncthreads();
  }
}

constexpr int TC = 8;
constexpr int PRF = 592;
constexpr int CHF = 4 * PRF + TC * 16;
__device__ __forceinline__ float rowsum16(float v) {
  v += dppx<0xB1>(v);
  v += dppx<0x4E>(v);
  v += dppx<0x141>(v);
  v += dppx<0x128>(v);
  return v;
}
__device__ __forceinline__ float dot4(float a0, float a1, float a2, float a3, const float4& b) {
  return fmaf(a1, b.y, a0 * b.x) + fmaf(a3, b.w, a2 * b.z);
}
__device__ void rwscan_item(const Params& p, int l, int item, unsigned char* ldsraw) {
  float* lp = (float*)ldsraw;
  const u32* rwp = (const u32*)(p.ws + WS_RWP);
  const int tid = opaque_tid(), lane = tid & 63, wave = tid >> 6;
  const int bh = item >> 2, q4 = item & 3;
  const int b = bh / 6, h = bh % 6;
  const size_t tokb = (size_t)b * T;
  const int cg = lane & 15, rsel = lane >> 4;
  const int nch = T / TC;
  if (wave >= 4) {
    const int j = wave - 4;
    const u32* src = rwp + ((tokb + 2 * j) * 384 + h * 64 + lane) * 3;
    const u16* srcv = (const u16*)(p.ws + WS_VY) + (tokb + 2 * j + ((lane >> 4) & 1)) * 384 + h * 64 + q4 * 16 + (lane & 15);
    u32 S0[6], S1[6], S2[6], S3[6]; u16 V0, V1, V2, V3;
    int ready_chunk = -1;
    const u32* prep_done = (const u32*)(p.ws + WS_CTRL) + 512 + l * 256;
    u32* scan_done = (u32*)(p.ws + WS_CTRL) + 1024 + l * 256;
#define LD_SET(S, V, chunk) { \
      const int cc_ = (chunk) < nch ? (chunk) : nch - 1; \
      if ((cc_ & 7) == 0 && cc_ > ready_chunk) { \
          \
        const u32* rc_ = prep_done + b * 64 + (cc_ >> 3); \
        while (__hip_atomic_load(rc_, __ATOMIC_RELAXED, __HIP_MEMORY_SCOPE_AGENT) < 4u) __builtin_amdgcn_s_sleep(4); \
        __builtin_amdgcn_fence(__ATOMIC_ACQUIRE, "agent"); \
        asm volatile("s_waitcnt vmcnt(0)" ::: "memory"); \
        ready_chunk = cc_; \
      } \
      const size_t go = (size_t)cc_ * TC * 384 * 3; \
      S[0] = src[go]; S[1] = src[go + 1]; S[2] = src[go + 2]; S[3] = src[go + 1152]; S[4] = src[go + 1153]; S[5] = src[go + 1154]; \
      V = srcv[(size_t)cc_ * TC * 384]; }
#define PROC_SET(S, V, buf) { \
      const float w1 = __uint_as_float(S[0]), kk1 = __uint_as_float(S[1] << 16), b1 = __uint_as_float(S[1] & 0xffff0000u); \
      const float km1 = __uint_as_float(S[2] << 16), r1 = __uint_as_float(S[2] & 0xffff0000u); \
      const float w2 = __uint_as_float(S[3]), kk2 = __uint_as_float(S[4] << 16), b2 = __uint_as_float(S[4] & 0xffff0000u); \
      const float km2 = __uint_as_float(S[5] << 16), r2 = __uint_as_float(S[5] & 0xffff0000u); \
      const float U0 = w1 * w2, U1 = b1 * w2, U2 = km1 * w2; \
      float* pb = lp + (buf) * CHF + j * PRF; \
      pb[lane] = kk1; pb[64 + lane] = w1 * kk2; pb[128 + lane] = w1 * r1; pb[192 + lane] = U0 * r2; \
      pb[256 + lane] = U0; pb[320 + lane] = U1; pb[384 + lane] = U2; pb[448 + lane] = b2; pb[512 + lane] = km2; \
      const float c1 = wsum_dpp63(b1 * kk2), c2 = wsum_dpp63(km1 * kk2), c3 = wsum_dpp63(b1 * r1), c4 = wsum_dpp63(km1 * r1); \
      const float c5 = wsum_dpp63(U1 * r2), c6 = wsum_dpp63(U2 * r2), c7 = wsum_dpp63(b2 * r2), c8 = wsum_dpp63(km2 * r2); \
      if (lane == 63) { *(float4*)(pb + 576) = make_float4(c1, c2, c3, c4); *(float4*)(pb + 580) = make_float4(c5, c6, c7, c8); } \
      if (lane < 32) lp[(buf) * CHF + 4 * PRF + (2 * j + (lane >> 4)) * 16 + (lane & 15)] = bf2f(V); }
    LD_SET(S0, V0, 0);
    PROC_SET(S0, V0, 0);
    LD_SET(S1, V1, 1);
    LD_SET(S2, V2, 2);
    LD_SET(S3, V3, 3);
    LD_SET(S0, V0, 4);
    lds_barrier();
    for (int ch = 0; ch < nch; ch += 4) {
      PROC_SET(S1, V1, 1); LD_SET(S1, V1, ch + 5); lds_barrier();
      PROC_SET(S2, V2, 0); LD_SET(S2, V2, ch + 6); lds_barrier();
      PROC_SET(S3, V3, 1); LD_SET(S3, V3, ch + 7); lds_barrier();
      PROC_SET(S0, V0, 0); LD_SET(S0, V0, ch + 8); lds_barrier();
      if (((ch + 4) & 7) == 0 && ch + 4 >= 16 && wave == 4 && lane == 0) {
        __hip_atomic_fetch_add(scan_done + b * 64 + ((ch + 4) >> 3) - 2, 1u, __ATOMIC_RELAXED, __HIP_MEMORY_SCOPE_AGENT);
      }
    }
#undef LD_SET
#undef PROC_SET
  } else {
    typedef float f32x2 __attribute__((ext_vector_type(2)));
    f32x2 sa = {0.f, 0.f}, sb = {0.f, 0.f};
    const int row = q4 * 16 + wave * 4 + rsel;
    const bool bit0 = (lane & 1) != 0, bit1 = (lane & 2) != 0, isy1 = (cg & 3) == 2;
    u16* yl = (u16*)(p.ws + WS_ABUF) + (tokb + 2 * (cg >> 2) + (cg & 1)) * D + 384 + h * 64 + row;
    lds_barrier();
    for (int ch = 0; ch < nch; ++ch) {
      const float* cb = lp + (ch & 1) * CHF;
      float yv[4];
#pragma unroll
      for (int j = 0; j < 4; ++j) {
        const f32x2* pb = (const f32x2*)(cb + j * PRF + cg * 4);
#define LDV(k, lo, hi) const f32x2 lo = pb[(k) * 32], hi = pb[(k) * 32 + 1];
        LDV(0, A1a, A1b) LDV(1, A2a, A2b) LDV(2, A3a, A3b) LDV(3, A4a, A4b)
        LDV(4, U0a, U0b) LDV(5, U1a, U1b) LDV(6, U2a, U2b) LDV(7, U3a, U3b) LDV(8, U4a, U4b)
#undef LDV
        const float4 ca = *(const float4*)(cb + j * PRF + 576), cc = *(const float4*)(cb + j * PRF + 580);
        const float v1 = cb[4 * PRF + (2 * j) * 16 + wave * 4 + rsel];
        const float v2 = cb[4 * PRF + (2 * j + 1) * 16 + wave * 4 + rsel];
        f32x2 t1 = sa * A1a + sb * A1b, t2 = sa * A2a + sb * A2b, t3 = sa * A3a + sb * A3b, t4 = sa * A4a + sb * A4b;
        const float p1 = t1.x + t1.y, p2 = t2.x + t2.y, p3 = t3.x + t3.y, p4 = t4.x + t4.y;
        const float u12 = (bit0 ? p2 : p1) + dppx<0xB1>(bit0 ? p1 : p2);
        const float u34 = (bit0 ? p4 : p3) + dppx<0xB1>(bit0 ? p3 : p4);
        float wq = (bit1 ? u34 : u12) + dppx<0x4E>(bit1 ? u12 : u34);
        wq += dppx<0x124>(wq);
        wq += dppx<0x128>(wq);
        const float d1 = -dppx<0x00>(wq);
        const float d2 = -(dppx<0x55>(wq) + d1 * ca.x + v1 * ca.y);
        const float e1 = isy1 ? ca.z : cc.x, e2 = isy1 ? ca.w : cc.y, e3 = isy1 ? 0.f : cc.z, e4 = isy1 ? 0.f : cc.w;
        yv[j] = wq + d1 * e1 + v1 * e2 + d2 * e3 + v2 * e4;
        sa = sa * U0a + d1 * U1a + v1 * U2a + d2 * U3a + v2 * U4a;
        sb = sb * U0b + d1 * U1b + v1 * U2b + d2 * U3b + v2 * U4b;
      }
      {
        float ym = 0.f;
#pragma unroll
        for (int jj = 0; jj < 4; ++jj) ym = ((cg >> 2) == jj) ? yv[jj] : ym;
        if ((cg & 2) != 0) __hip_atomic_store(yl, f2bf(ym), __ATOMIC_RELAXED, __HIP_MEMORY_SCOPE_AGENT);
        yl += (size_t)TC * D;
      }
      if ((ch & 7) == 7) asm volatile("s_waitcnt vmcnt(8)" ::: "memory");
      lds_barrier();
    }
  }
  __syncthreads();
  if (tid == 256) __hip_atomic_fetch_add((u32*)(p.ws + WS_CTRL) + 1024 + l * 256 + b * 64 + 63, 1u, __ATOMIC_RELAXED, __HIP_MEMORY_SCOPE_AGENT);
}

constexpr int KLD = 72;
__device__ void sbattn_item(const Params& p, int l, int item, unsigned char* ldsraw) {
  u16* Ks = (u16*)ldsraw;
  u16* Vt = Ks + 64 * KLD;
  const u16* proj = (const u16*)(p.ws + WS_PROJ);
  u16* mix = (u16*)(p.ws + WS_ABUF);
  const float* ng = p.in[3] + l * 384;
  const int tid = opaque_tid(), lane = tid & 63, wave = tid >> 6;
  const int l15 = lane & 15, g4 = lane >> 4;
  const int bh = item % 24, qb = 31 - item / 24;
  const int b = bh / 6, h = bh % 6;
  const size_t tokb = (size_t)b * T;
  const int Q0 = qb * 128, q0 = Q0 + wave * 16;
  const int qi = q0 + l15;
  bf16x8 bq[2];
#pragma unroll
  for (int ks = 0; ks < 2; ++ks)
    bq[ks] = *(const bf16x8*)(proj + (tokb + qi) * INW + SBQ + h * 64 + ks * 32 + g4 * 8);
  bf16x8 P0, P1, ONES;
#pragma unroll
  for (int i = 0; i < 8; ++i) {
    const int jj = (i < 4) ? (4 * g4 + i) : (16 + 4 * g4 + (i - 4));
    P0[i] = (jj > l15) ? (short)0x3F80 : (short)0;
    P1[i] = (jj > 16 + l15) ? (short)0x3F80 : (short)0;
    ONES[i] = (short)0x3F80;
  }
  f32x4 ot[4];
#pragma unroll
  for (int i = 0; i < 4; ++i) ot[i] = (f32x4){0.f, 0.f, 0.f, 0.f};
  float carry = 0.f;
  const float SC = 0.125f * LOG2E;
  const int kb_hi = 2 * qb + 1;
  const int kb_diag = q0 >> 6;
  for (int kb = kb_hi; kb >= 0; --kb) {
    if (__syncthreads_and(carry < -151.f)) break;
    {
      const int key = tid >> 3, ch = tid & 7;
      const u16* src = proj + (tokb + kb * 64 + key) * INW + h * 64 + ch * 8;
      const uint4 kv = *(const uint4*)(src + SBK);
      const uint4 vv = *(const uint4*)(src + SBV);
      *(uint4*)(Ks + key * KLD + ch * 8) = kv;
      const u32 w[4] = {vv.x, vv.y, vv.z, vv.w};
#pragma unroll
      for (int i = 0; i < 4; ++i) {
        Vt[(ch * 8 + 2 * i) * KLD + key] = (u16)(w[i] & 0xffffu);
        Vt[(ch * 8 + 2 * i + 1) * KLD + key] = (u16)(w[i] >> 16);
      }
    }
    __syncthreads();
    if (kb > kb_diag) continue;
    f32x4 st[4];
#pragma unroll
    for (int f = 0; f < 4; ++f) {
      st[f] = (f32x4){0.f, 0.f, 0.f, 0.f};
#pragma unroll
      for (int ks = 0; ks < 2; ++ks) {
        const bf16x8 ak = *(const bf16x8*)(Ks + (f * 16 + l15) * KLD + ks * 32 + g4 * 8);
        st[f] = __builtin_amdgcn_mfma_f32_16x16x32_bf16(ak, bq[ks], st[f], 0, 0, 0);
      }
    }
    float e0[4][4];
    bf16x8 lb[2];
    const bool diag = (kb == kb_diag);
#pragma unroll
    for (int f = 0; f < 4; ++f)
#pragma unroll
      for (int j = 0; j < 4; ++j) {
        const float t = st[f][j] * SC;
        float lv = -(fmaxf(t, 0.f) + __builtin_amdgcn_logf(1.f + __builtin_amdgcn_exp2f(-fabsf(t))));
        e0[f][j] = t + lv;
        if (diag) { const int key = kb * 64 + 16 * f + 4 * g4 + j; if (key >= qi) lv = 0.f; }
        lb[f >> 1][(f & 1) * 4 + j] = (short)f2bf(lv);
      }
    const f32x4 cv = (f32x4){carry, carry, carry, carry};
    f32x4 tot = __builtin_amdgcn_mfma_f32_16x16x32_bf16(ONES, lb[0], cv, 0, 0, 0);
    tot = __builtin_amdgcn_mfma_f32_16x16x32_bf16(ONES, lb[1], tot, 0, 0, 0);
    bf16x8 wb[2];
#pragma unroll
    for (int f = 0; f < 4; ++f) {
      f32x4 bt;
      if (f == 0) { bt = __builtin_amdgcn_mfma_f32_16x16x32_bf16(P0, lb[0], cv, 0, 0, 0); bt = __builtin_amdgcn_mfma_f32_16x16x32_bf16(ONES, lb[1], bt, 0, 0, 0); }
      else if (f == 1) { bt = __builtin_amdgcn_mfma_f32_16x16x32_bf16(P1, lb[0], cv, 0, 0, 0); bt = __builtin_amdgcn_mfma_f32_16x16x32_bf16(ONES, lb[1], bt, 0, 0, 0); }
      else if (f == 2) bt = __builtin_amdgcn_mfma_f32_16x16x32_bf16(P0, lb[1], cv, 0, 0, 0);
      else bt = __builtin_amdgcn_mfma_f32_16x16x32_bf16(P1, lb[1], cv, 0, 0, 0);
#pragma unroll
      for (int j = 0; j < 4; ++j) {
        float w = __builtin_amdgcn_exp2f(e0[f][j] + bt[j]);
        if (diag) { const int key = kb * 64 + 16 * f + 4 * g4 + j; if (key >= qi) w = 0.f; }
        wb[f >> 1][(f & 1) * 4 + j] = (short)f2bf(w);
      }
    }
#pragma unroll
    for (int df = 0; df < 4; ++df)
#pragma unroll
      for (int k2 = 0; k2 < 2; ++k2) {
        const u16* vp = Vt + (df * 16 + l15) * KLD + k2 * 32 + 4 * g4;
        const uint2 lo = *(const uint2*)(vp);
        const uint2 hi = *(const uint2*)(vp + 16);
        bf16x8 av;
        av[0] = (short)(lo.x & 0xffff); av[1] = (short)(lo.x >> 16); av[2] = (short)(lo.y & 0xffff); av[3] = (short)(lo.y >> 16);
        av[4] = (short)(hi.x & 0xffff); av[5] = (short)(hi.x >> 16); av[6] = (short)(hi.y & 0xffff); av[7] = (short)(hi.y >> 16);
        ot[df] = __builtin_amdgcn_mfma_f32_16x16x32_bf16(av, wb[k2], ot[df], 0, 0, 0);
      }
    carry = tot[0];
  }
  float ss = 0.f;
#pragma unroll
  for (int df = 0; df < 4; ++df)
#pragma unroll
    for (int j = 0; j < 4; ++j) ss += ot[df][j] * ot[df][j];
  ss += __shfl_xor(ss, 16, 64);
  ss += __shfl_xor(ss, 32, 64);
  const float rs = rsqrtf(ss * (1.f / 64.f) + EPS);
#pragma unroll
  for (int df = 0; df < 4; ++df) {
    const int d = 16 * df + 4 * g4;
    const float4 gg = *(const float4*)(ng + h * 64 + d);
    uint2 o;
    o.x = pack2(ot[df][0] * rs * gg.x, ot[df][1] * rs * gg.y);
    o.y = pack2(ot[df][2] * rs * gg.z, ot[df][3] * rs * gg.w);
    *(uint2*)(mix + (tokb + qi) * D + h * 64 + d) = o;
  }
  __syncthreads();
}

__device__ void gla_load(const Params& p, int l, int b, int h, int c, float* qs, float* ks, float* vs, float* bc, float* gds) {
  const u16* proj = (const u16*)(p.ws + WS_PROJ);
  const float* gate_up = p.in[15] + l * 16 * 128;
  const float* gate_b = p.in[16] + l * 128;
  const int tid = opaque_tid();
  const size_t tok0 = (size_t)b * T + c * 64;
  const float qsc = 0.17677669529663687f;
  for (int e = tid; e < 64 * 32; e += NT) {
    const int t = e >> 5, k = e & 31;
    const u16* pr = proj + (tok0 + t) * INW + GL0;
    qs[e] = bf2f(pr[h * 32 + k]) * qsc;
    ks[e] = bf2f(pr[128 + h * 32 + k]);
  }
  for (int e = tid; e < 64 * 64; e += NT) {
    const int t = e >> 6, v = e & 63;
    vs[e] = bf2f(proj[(tok0 + t) * INW + GL0 + 256 + h * 64 + v]);
  }
  for (int e = tid; e < 64 * 16; e += NT) {
    const int t = e >> 4, j = e & 15;
    gds[e] = bf2f(proj[(tok0 + t) * INW + GL0 + 512 + j]);
  }
  __syncthreads();
  for (int e = tid; e < 64 * 32; e += NT) {
    const int t = e >> 5, k = e & 31;
    float x = gate_b[h * 32 + k];
#pragma unroll
    for (int j = 0; j < 16; ++j) x += gds[t * 16 + j] * gate_up[j * 128 + h * 32 + k];
    bc[e] = -softplus_f(-x) * (1.f / 16.f);
  }
  __syncthreads();
  {
    const int k = tid & 31, seg = (tid >> 5) & 7;
    float v[8];
    if (tid < 256) {
      float a = 0.f;
#pragma unroll
      for (int i = 0; i < 8; ++i) { a += bc[(seg * 8 + i) * 32 + k]; v[i] = a; }
#pragma unroll
      for (int i = 0; i < 8; ++i) bc[(seg * 8 + i) * 32 + k] = v[i];
    }
    __syncthreads();
    float off = 0.f;
    if (tid < 256) for (int s2 = 0; s2 < seg; ++s2) off += bc[(s2 * 8 + 7) * 32 + k];
    __syncthreads();
    if (tid < 256) {
#pragma unroll
      for (int i = 0; i < 8; ++i) bc[(seg * 8 + i) * 32 + k] = v[i] + off;
    }
  }
  __syncthreads();
}

__device__ void gla_passA_item(const Params& p, int l, int item, unsigned char* ldsraw) {
  float* qs = (float*)ldsraw; float* ks = qs + 2048; float* vs = ks + 2048; float* bc = vs + 4096;
  float* sc = bc + 2048; float* S0 = sc + 4096; float* gds = S0 + 2048;
  const int c = item & 63, bh = item >> 6, b = bh >> 2, h = bh & 3;
  gla_load(p, l, b, h, c, qs, ks, vs, bc, gds);
  const int tid = opaque_tid();
  float* kd = sc;
  for (int e = tid; e < 2048; e += NT) {
    const int k = e & 31;
    kd[e] = ks[e] * __expf(bc[63 * 32 + k] - bc[e]);
  }
  __syncthreads();
  float* gS = (float*)(p.ws + WS_GLAS) + (size_t)item * 2048;
  float* gD = (float*)(p.ws + WS_GLAD) + (size_t)item * 32;
  for (int e = tid; e < 2048; e += NT) {
    const int k = e >> 6, v = e & 63;
    float a = 0.f;
#pragma unroll 8
    for (int s = 0; s < 64; ++s) a += kd[s * 32 + k] * vs[s * 64 + v];
    gS[e] = a;
  }
  if (tid < 32) gD[tid] = __expf(bc[63 * 32 + tid]);
  __syncthreads();
}

__device__ void gla_passC_item(const Params& p, int l, int item, unsigned char* ldsraw) {
  float* qs = (float*)ldsraw; float* ks = qs + 2048; float* vs = ks + 2048; float* bc = vs + 4096;
  float* sc = bc + 2048; float* S0 = sc + 4096; float* gds = S0 + 2048;
  const int c = item & 63, bh = item >> 6, b = bh >> 2, h = bh & 3;
  gla_load(p, l, b, h, c, qs, ks, vs, bc, gds);
  const int tid = opaque_tid();
  const u16* proj = (const u16*)(p.ws + WS_PROJ);
  u16* mix = (u16*)(p.ws + WS_ABUF);
  const float* norm_g = p.in[17] + l * 256;
  const bool wide = __syncthreads_or(tid < 32 && bc[63 * 32 + tid] < -60.f) != 0;
  if (!wide) {
    float qv[4], kv[4];
#pragma unroll
    for (int i = 0; i < 4; ++i) {
      const int e = tid + NT * i, k = e & 31;
      const float m = bc[32 * 32 + k];
      qv[i] = qs[e] * __expf(bc[e] - m);
      kv[i] = ks[e] * __expf(m - bc[e]);
    }
    __syncthreads();
    float* QpT = S0;
    float* KpT = ks;
#pragma unroll
    for (int i = 0; i < 4; ++i) {
      const int e = tid + NT * i, t = e >> 5, k = e & 31;
      QpT[k * 64 + t] = qv[i];
      KpT[k * 64 + t] = kv[i];
    }
    __syncthreads();
    {
      const int t0 = (tid >> 4) * 2, s0 = (tid & 15) * 4;
      float a0[4] = {0.f, 0.f, 0.f, 0.f}, a1[4] = {0.f, 0.f, 0.f, 0.f};
#pragma unroll 8
      for (int k = 0; k < 32; ++k) {
        const float2 q2 = *(const float2*)(QpT + k * 64 + t0);
        const float4 k4 = *(const float4*)(KpT + k * 64 + s0);
        a0[0] += q2.x * k4.x; a0[1] += q2.x * k4.y; a0[2] += q2.x * k4.z; a0[3] += q2.x * k4.w;
        a1[0] += q2.y * k4.x; a1[1] += q2.y * k4.y; a1[2] += q2.y * k4.z; a1[3] += q2.y * k4.w;
      }
#pragma unroll
      for (int jx = 0; jx < 4; ++jx) {
        sc[t0 * 64 + s0 + jx] = (s0 + jx <= t0) ? a0[jx] : 0.f;
        sc[(t0 + 1) * 64 + s0 + jx] = (s0 + jx <= t0 + 1) ? a1[jx] : 0.f;
      }
    }
  } else {
    for (int e = tid; e < 4096; e += NT) {
      const int t = e >> 6, s = e & 63;
      float a = 0.f;
      if (s <= t) {
#pragma unroll 4
        for (int k = 0; k < 32; ++k) a += qs[t * 32 + k] * ks[s * 32 + k] * __expf(bc[t * 32 + k] - bc[s * 32 + k]);
      }
      sc[e] = a;
    }
  }
  __syncthreads();
  {
    const float* gS = (const float*)(p.ws + WS_GLAS) + (size_t)(bh * 64) * 2048;
    const float* gD = (const float*)(p.ws + WS_GLAD) + (size_t)(bh * 64) * 32;
    float a[4] = {0.f, 0.f, 0.f, 0.f};
#pragma unroll 8
    for (int cc = 0; cc < c; ++cc) {
#pragma unroll
      for (int i = 0; i < 4; ++i) {
        const int e = tid + NT * i;
        a[i] = a[i] * gD[cc * 32 + (e >> 6)] + gS[(size_t)cc * 2048 + e];
      }
    }
#pragma unroll
    for (int i = 0; i < 4; ++i) S0[tid + NT * i] = a[i];
  }
  for (int e = tid; e < 2048; e += NT) qs[e] *= __expf(bc[e]);
  __syncthreads();
  {
    const int t = tid >> 3, v0 = (tid & 7) * 8;
    float o[8];
#pragma unroll
    for (int i = 0; i < 8; ++i) o[i] = 0.f;
#pragma unroll 2
    for (int s = 0; s <= t; ++s) {
      const float w = sc[t * 64 + s];
#pragma unroll
      for (int i = 0; i < 8; ++i) o[i] += w * vs[s * 64 + v0 + i];
    }
#pragma unroll 2
    for (int k = 0; k < 32; ++k) {
      const float w = qs[t * 32 + k];
#pragma unroll
      for (int i = 0; i < 8; ++i) o[i] += w * S0[k * 64 + v0 + i];
    }
    float ss = 0.f;
#pragma unroll
    for (int i = 0; i < 8; ++i) ss += o[i] * o[i];
    ss += __shfl_xor(ss, 1, 64); ss += __shfl_xor(ss, 2, 64); ss += __shfl_xor(ss, 4, 64);
    const float rs = rsqrtf(ss * (1.f / 64.f) + EPS);
    const size_t tok = (size_t)b * T + c * 64 + t;
    u32 ow[4];
    float r2[8];
#pragma unroll
    for (int i = 0; i < 8; ++i) {
      const float g = bf2f(proj[tok * INW + GL0 + 528 + h * 64 + v0 + i]);
      const float sil = g / (1.f + __expf(-g));
      r2[i] = o[i] * rs * norm_g[h * 64 + v0 + i] * sil;
    }
#pragma unroll
    for (int i = 0; i < 4; ++i) ow[i] = pack2(r2[2 * i], r2[2 * i + 1]);
    *(uint4*)(mix + tok * D + 768 + h * 64 + v0) = make_uint4(ow[0], ow[1], ow[2], ow[3]);
  }
  __syncthreads();
}

__device__ void rwfinal_items(const Params& p, int l, unsigned char* ldsraw, int it_begin, int it_end, int it_step, bool stage_gup) {
  float* codes = (float*)ldsraw;
  u16* gul = (u16*)(ldsraw + 4096);
  const u16* proj = (const u16*)(p.ws + WS_PROJ);
  const u32* rwp = (const u32*)(p.ws + WS_RWP);
  const u16* vy = (const u16*)(p.ws + WS_VY);
  u16* mix = (u16*)(p.ws + WS_ABUF);
  const float* mu = p.in[4] + l * 1280;
  const float* g_up = p.in[9] + l * 64 * 384;
  const float* bon = (const float*)(p.ws + WS_CTRL + 65536);
  const float* gn_g = p.in[13] + l * 384;
  const float* gn_b = p.in[14] + l * 384;
  const int tid = opaque_tid();
  if (stage_gup) { for (int e = tid; e < 64 * 384; e += NT) gul[e] = f2bf(g_up[e]); }
  __syncthreads();
  for (int it = it_begin; it < it_end; it += it_step) {
    const int tok0 = it * 8;
    {
      const int tt = tid >> 6, j = tid & 63;
      const int tok = tok0 + tt;
      const int col = 1216 + j;
      const float pc = bf2f(proj[(size_t)tok * INW + RW0 + col]);
      const float pp = (tok % T == 0) ? 0.f : bf2f(proj[(size_t)(tok - 1) * INW + RW0 + col]);
      const float s = pc + (pp - pc) * mu[col];
      codes[tt * 64 + j] = 1.f / (1.f + __expf(-s));
    }
    __syncthreads();
    if (tid < 384) {
      const int c = tid;
      float ag[8], pv[8], py[8], pbn[8];
#pragma unroll
      for (int tt = 0; tt < 8; ++tt) {
        ag[tt] = 0.f;
        pv[tt] = bf2f(vy[(size_t)(tok0 + tt) * 384 + c]);
        py[tt] = bf2f(mix[(size_t)(tok0 + tt) * D + 384 + c]);
        pbn[tt] = bon[(size_t)(tok0 + tt) * 6 + (tid >> 6)];
      }
#pragma unroll 8
      for (int j = 0; j < 64; ++j) {
        const float gu = bf2f(gul[j * 384 + c]);
#pragma unroll
        for (int tt = 0; tt < 8; ++tt) ag[tt] += codes[tt * 64 + j] * gu;
      }
      const float gg = gn_g[c], gb = gn_b[c];
#pragma unroll
      for (int tt = 0; tt < 8; ++tt) {
        const float v = pv[tt], y = py[tt];
        const int tok = tok0 + tt;
        const float mean = wsum_u(y) * (1.f / 64.f);
        const float dv = y - mean;
        const float var = wsum_u(dv * dv) * (1.f / 64.f);
        const float yn = dv * rsqrtf(var + 64e-5f) * gg + gb;
        const float bonus = pbn[tt] * v;
        mix[(size_t)tok * D + 384 + c] = f2bf((yn + bonus) * ag[tt]);
      }
    }
    __syncthreads();
  }
}

__device__ __forceinline__ void fast_grid_barrier(u32* bw, u32 k, int G) {
  asm volatile("s_waitcnt vmcnt(0)" ::: "memory");
  __syncthreads();
  if (threadIdx.x == 0) {
    const u32 x = blockIdx.x & 7u, per = ((u32)G - x + 7u) >> 3;
    u32* A = bw + 16 * x; u32* W = bw + 16 * 8; u32* F = bw + 16 * (9 + x);
    __builtin_amdgcn_fence(__ATOMIC_RELEASE, "agent");
    asm volatile("s_waitcnt vmcnt(0)" ::: "memory");
    const u32 old = __hip_atomic_fetch_add(A, 1u, __ATOMIC_RELAXED, __HIP_MEMORY_SCOPE_AGENT);
    if (old + 1u == per * k) {
      const u32 oldw = __hip_atomic_fetch_add(W, 1u, __ATOMIC_RELAXED, __HIP_MEMORY_SCOPE_AGENT);
      if (oldw + 1u == 8u * k) {
        for (int i = 0; i < 8; ++i) __hip_atomic_store(bw + 16 * (9 + i), k, __ATOMIC_RELAXED, __HIP_MEMORY_SCOPE_AGENT);
      }
    }
    while (__hip_atomic_load(F, __ATOMIC_RELAXED, __HIP_MEMORY_SCOPE_AGENT) < k) __builtin_amdgcn_s_sleep(2);
    __builtin_amdgcn_fence(__ATOMIC_ACQUIRE, "agent");
    asm volatile("s_waitcnt vmcnt(0)" ::: "memory");
  }
  __syncthreads();
}

constexpr int LDS_BYTES = 147456;
#ifndef RES_TEST_ONLY
constexpr int N_SCAN_ITEMS = 96;
constexpr int N_ATT_ITEMS = 768;
constexpr int N_GLA_ITEMS = 1024;
constexpr int N_PREP_ITEMS = M / 16;
constexpr int N_FIN_ITEMS = M / 8;

template <bool COOP>
__global__ void __launch_bounds__(NT, 2) mega(Params p) {
  extern __shared__ __attribute__((aligned(16))) unsigned char lds[];
  int& s_item = *(int*)(lds + LDS_BYTES);
  const int G = gridDim.x;
  unsigned char* ws = p.ws;
  u32* ctr = (u32*)(ws + WS_CTRL);
  u16* abuf = (u16*)(ws + WS_ABUF);
  u16* cbuf = (u16*)(ws + WS_CBUF);
  u16* ffh = (u16*)(ws + WS_FFH);
  u16* proj = (u16*)(ws + WS_PROJ);
  u32 nbar = 0;
#pragma nounroll
  for (int ph = p.phase_lo; ph < p.phase_hi; ++ph) {
    const int l = (ph == 0) ? 0 : (ph - 1) / 9;
    const int kind = (ph == 0) ? 0 : 1 + (ph - 1) % 9;
    for (int rep = 0; rep < (((REPEAT_MASK >> kind) & 1) ? 2 : 1); ++rep) {
    if (rep) __syncthreads();
    switch (kind) {
      case 0:
        if (blockIdx.x == 0) { const int t0 = opaque_tid(); ctr[t0] = 0u; ctr[t0 + 512] = 0u; ctr[t0 + 1024] = 0u; ctr[t0 + 1536] = 0u; }
        prep_weights_layer(p, 0, (float*)lds, G);
        row_phase(p.in[0], nullptr, nullptr, nullptr, abuf, G);
        break;
      case 1:
        gemm_phase<EPI_BF16>(abuf, (const u16*)(ws + WS_WIN), proj, INW, D, INW, lds, G);
        break;
      case 2:
        break;
      case 3: {
#ifndef REP_SCAN
#define REP_SCAN 1
#endif
#ifndef REP_QUEUE
#define REP_QUEUE 1
#endif
        for (int r2 = 0; r2 < REP_SCAN; ++r2) {
        if (G > N_SCAN_ITEMS) {
          if ((int)blockIdx.x < N_SCAN_ITEMS) rwscan_item(p, l, blockIdx.x, lds);
        } else {
          for (int it = blockIdx.x; it < N_SCAN_ITEMS; it += G) rwscan_item(p, l, it, lds);
        }
        }
        bool gul_ready = false;
        for (int r2 = 0; r2 < REP_QUEUE; ++r2)
        for (;;) {
          __syncthreads();
          if (opaque_tid() == 0) s_item = (int)atomicAdd(&ctr[l + 2 * rep + 4 * r2], 1u);
          __syncthreads();
          int it = s_item;
          if (it >= N_PREP_ITEMS + N_ATT_ITEMS + 2 * N_GLA_ITEMS + N_FIN_ITEMS) break;
          if (it >= N_PREP_ITEMS + N_ATT_ITEMS + 2 * N_GLA_ITEMS) {
            const int fi = it - (N_PREP_ITEMS + N_ATT_ITEMS + 2 * N_GLA_ITEMS);
            const int within = fi & 7, rr = fi >> 3, bb = rr & 3, tb = rr >> 2;
            if (opaque_tid() == 0) {
              const u32* sd = ctr + 1024 + l * 256 + bb * 64 + tb;
              while (__hip_atomic_load(sd, __ATOMIC_RELAXED, __HIP_MEMORY_SCOPE_AGENT) < 24u) __builtin_amdgcn_s_sleep(100);
              __builtin_amdgcn_fence(__ATOMIC_ACQUIRE, "agent");
              asm volatile("s_waitcnt vmcnt(0)" ::: "memory");
            }
            __syncthreads();
            const int fit = (bb * T + tb * 64) / 8 + within;
            rwfinal_items(p, l, lds, fit, fit + 1, 1, !gul_ready);
            gul_ready = true;
            continue;
          }
          gul_ready = false;
          if (it < N_PREP_ITEMS) {
            const int within = it & 3, rr = it >> 2, bb = rr & 3, tb = rr >> 2;
            const int pit = (bb * T + tb * 64) / 4 + within * 4;
            rwprep_items(p, l, lds, pit, pit + 4, 1);
            asm volatile("s_waitcnt vmcnt(0)" ::: "memory");
            __syncthreads();
            if (opaque_tid() == 0) {
              __builtin_amdgcn_fence(__ATOMIC_RELEASE, "agent");
              asm volatile("s_waitcnt vmcnt(0)" ::: "memory");
              __hip_atomic_fetch_add(ctr + 512 + l * 256 + bb * 64 + tb, 1u, __ATOMIC_RELAXED, __HIP_MEMORY_SCOPE_AGENT);
            }
            continue;
          }
          it -= N_PREP_ITEMS;
          u32* glaA_done = ctr + 40 + l;
          if (it < N_GLA_ITEMS) {
            gla_passA_item(p, l, it, lds);
            asm volatile("s_waitcnt vmcnt(0)" ::: "memory");
            __syncthreads();
            if (opaque_tid() == 0) {
              __builtin_amdgcn_fence(__ATOMIC_RELEASE, "agent");
              asm volatile("s_waitcnt vmcnt(0)" ::: "memory");
              __hip_atomic_fetch_add(glaA_done, 1u, __ATOMIC_RELAXED, __HIP_MEMORY_SCOPE_AGENT);
            }
          } else if (it < N_GLA_ITEMS + N_ATT_ITEMS) {
            sbattn_item(p, l, it - N_GLA_ITEMS, lds);
          } else {
            if (opaque_tid() == 0) {
              while (__hip_atomic_load(glaA_done, __ATOMIC_RELAXED, __HIP_MEMORY_SCOPE_AGENT) < (u32)N_GLA_ITEMS) __builtin_amdgcn_s_sleep(8);
              __builtin_amdgcn_fence(__ATOMIC_ACQUIRE, "agent");
              asm volatile("s_waitcnt vmcnt(0)" ::: "memory");
            }
            __syncthreads();
            gla_passC_item(p, l, it - N_GLA_ITEMS - N_ATT_ITEMS, lds);
          }
        }
      } break;
      case 4:
        break;
      case 5:
        gemm_phase<EPI_BF16>(abuf, (const u16*)(ws + WS_WOUT), cbuf, D, D, D, lds, G);
        break;
      case 6:
        row_phase(l == 0 ? p.in[0] : p.out, cbuf, p.in[19] + l * D, p.out, abuf, G);
        break;
      case 7:
        gemm_phase<EPI_RELU2>(abuf, (const u16*)(ws + WS_WF1), ffh, DFF, D, DFF, lds, G);
        break;
      case 8:
        gemm_phase<EPI_BF16>(ffh, (const u16*)(ws + WS_WF2), cbuf, D, DFF, D, lds, G);
        break;
      default:
        row_phase(p.out, cbuf, p.in[23] + l * D, p.out, l == 0 ? abuf : nullptr, G);
        if (l == 0) prep_weights_layer(p, 1, (float*)lds, G);
        break;
    }
    }
    if (COOP) {
      if (ph + 1 < p.phase_hi && kind != 2 && kind != 4) {
        if (ph == 0) cg::this_grid().sync();
        else fast_grid_barrier(ctr + 64, ++nbar, G);
      }
    }
  }
}
constexpr int N_PHASES = 19;

extern "C" void kernel_launch(void* const* d_in, const int* in_sizes, int n_in, void* d_out, int out_size,
                              void* d_ws, size_t ws_size, hipStream_t stream) {
  Params p{};
  for (int i = 0; i < 24; ++i) p.in[i] = (const float*)d_in[i];
  p.out = (float*)d_out;
  p.ws = (unsigned char*)d_ws;
#if MULTI_LAUNCH
  for (int ph = 0; ph < N_PHASES; ++ph) {
    p.phase_lo = ph; p.phase_hi = ph + 1;
    hipLaunchKernelGGL(mega<false>, dim3(512), dim3(NT), LDS_BYTES + 16, stream, p);
  }
#else
  static int grid_blocks = 0;
  if (!grid_blocks) {
    int dev = 0, cus = 0, per_cu = 0;
    hipGetDevice(&dev);
    hipDeviceGetAttribute(&cus, hipDeviceAttributeMultiprocessorCount, dev);
    (void)hipFuncSetAttribute((const void*)mega<true>, hipFuncAttributeMaxDynamicSharedMemorySize, LDS_BYTES + 16);
    hipOccupancyMaxActiveBlocksPerMultiprocessor(&per_cu, mega<true>, NT, LDS_BYTES + 16);
    if (per_cu > 2) per_cu = 2;
    if (per_cu < 1) per_cu = 1;
    grid_blocks = cus * per_cu;
  }
  p.phase_lo = 0; p.phase_hi = N_PHASES;
  void* args[] = {&p};
  hipError_t e = hipLaunchCooperativeKernel((void*)mega<true>, dim3(grid_blocks), dim3(NT), args, LDS_BYTES + 16, stream);
  if (e != hipSuccess) fprintf(stderr, "cooperative launch failed: %s (grid %d)\n", hipGetErrorString(e), grid_blocks);
#endif
}
#endif
```

```cpp
#include <hip/hip_runtime.h>
#include <hip/hip_cooperative_groups.h>
#include <cstdio>
#include <cstdint>
namespace cg = cooperative_groups;

typedef unsigned short u16;
typedef unsigned int u32;
using bf16x8 = __attribute__((ext_vector_type(8))) short;
using f32x4 = __attribute__((ext_vector_type(4))) float;

#ifndef REPEAT_MASK
#define REPEAT_MASK 0
#endif
#ifndef MULTI_LAUNCH
#define MULTI_LAUNCH 0
#endif

constexpr int NT = 512;
constexpr int Bsz = 4, T = 4096, D = 1024, M = Bsz * T;
constexpr int INW = 3216, INP = 3328;
constexpr int DFF = 4096;
constexpr int SBQ = 0, SBK = 384, SBV = 768;
constexpr int RW0 = 1152;
constexpr int GL0 = 2432;
constexpr float EPS = 1e-6f;
constexpr float LOG2E = 1.4426950408889634f;

constexpr size_t WS_CTRL = 0;
constexpr size_t WS_WIN = 1u << 20;
constexpr size_t WS_WOUT = WS_WIN + (size_t)INP * D * 2;
constexpr size_t WS_WF1 = WS_WOUT + (size_t)D * D * 2;
constexpr size_t WS_WF2 = WS_WF1 + (size_t)DFF * D * 2;
constexpr size_t WS_ABUF = WS_WF2 + (size_t)DFF * D * 2;
constexpr size_t WS_BIG = WS_ABUF + (size_t)M * D * 2;
constexpr size_t WS_PROJ = WS_BIG;
constexpr size_t WS_RWP = WS_PROJ + (size_t)M * INW * 2;
constexpr size_t WS_VY = WS_RWP + (size_t)M * 384 * 12;
constexpr size_t WS_GLAS = WS_VY + (size_t)M * 384 * 2;
constexpr size_t WS_GLAD = WS_GLAS + (size_t)1024 * 2048 * 4;
constexpr size_t WS_MIX_END = WS_GLAD + (size_t)1024 * 32 * 4;
constexpr size_t WS_CBUF = WS_BIG;
constexpr size_t WS_FFH = WS_CBUF + (size_t)M * D * 4;
constexpr size_t WS_FFN_END = WS_FFH + (size_t)M * DFF * 2;
static_assert(WS_MIX_END <= (256u << 20) && WS_FFN_END <= (256u << 20), "workspace");

struct Params {
  const float* in[24];
  float* out;
  unsigned char* ws;
  int phase_lo, phase_hi;
};

__device__ __forceinline__ u16 f2bf(float f) {
  u32 u = __float_as_uint(f);
  u += 0x7fffu + ((u >> 16) & 1u);
  return (u16)(u >> 16);
}
__device__ __forceinline__ float bf2f(u16 h) { return __uint_as_float(((u32)h) << 16); }
__device__ __forceinline__ u32 pack2(float lo, float hi) { return (u32)f2bf(lo) | ((u32)f2bf(hi) << 16); }
__device__ __forceinline__ float wsum_shfl(float v) {
#pragma unroll
  for (int o = 32; o > 0; o >>= 1) v += __shfl_xor(v, o, 64);
  return v;
}
template <int CTRL>
__device__ __forceinline__ float dppx(float x) {
  return __builtin_bit_cast(float, __builtin_amdgcn_mov_dpp(__builtin_bit_cast(int, x), CTRL, 0xf, 0xf, true));
}
__device__ __forceinline__ float wsum_dpp63(float v) {
  v += dppx<0xB1>(v);
  v += dppx<0x4E>(v);
  v += dppx<0x141>(v);
  v += dppx<0x128>(v);
  v += dppx<0x142>(v);
  v += dppx<0x143>(v);
  return v;
}
__device__ __forceinline__ float rdlane63(float v);
__device__ __forceinline__ float wsum_u(float v) { return rdlane63(wsum_dpp63(v)); }
__device__ __forceinline__ float rdlane63(float v) {
  return __builtin_bit_cast(float, __builtin_amdgcn_readlane(__builtin_bit_cast(int, v), 63));
}
__device__ __forceinline__ void lds_barrier() { asm volatile("s_waitcnt lgkmcnt(0)\n\ts_barrier" ::: "memory"); }
__device__ __forceinline__ void glds16(const void* g, unsigned lds_base) {
  unsigned sv;
  asm volatile("s_mov_b32 %0, m0\n\ts_mov_b32 m0, %2\n\ts_nop 0\n\tglobal_load_lds_dwordx4 %1, off\n\ts_mov_b32 m0, %0"
               : "=&s"(sv) : "v"(g), "s"(lds_base) : "memory");
}
__device__ __forceinline__ int opaque_tid() { int t = threadIdx.x; asm volatile("" : "+v"(t)); return t; }
__device__ __forceinline__ float softplus_f(float x) {
  return fmaxf(x, 0.f) + __logf(1.f + __expf(-fabsf(x)));
}

__device__ void prep_weight(const float* __restrict__ W, const float* __restrict__ gain, u16* __restrict__ Wt,
                            int K, int N, int Npad, float* lds, int bid, int G) {
  const int tid = opaque_tid();
  const int tk_n = K / 64, tn_n = Npad / 64;
  for (int tile = bid; tile < tk_n * tn_n; tile += G) {
    const int tk = tile % tk_n, tn = tile / tk_n;
    const int k0 = tk * 64, n0 = tn * 64;
    const int j = tid & 63, i0 = tid >> 6;
#pragma unroll
    for (int r = 0; r < 8; ++r) {
      const int i = i0 + 8 * r;
      const int n = n0 + j;
      float v = 0.f;
      if (n < N) { v = W[(size_t)(k0 + i) * N + n]; if (gain) v *= gain[k0 + i]; }
      lds[i * 65 + j] = v;
    }
    __syncthreads();
#pragma unroll
    for (int r = 0; r < 4; ++r) {
      const int jn = (tid >> 5) + 16 * r;
      const int ik = (tid & 31) * 2;
      *(u32*)(Wt + (size_t)(n0 + jn) * K + k0 + ik) = pack2(lds[ik * 65 + jn], lds[(ik + 1) * 65 + jn]);
    }
    __syncthreads();
  }
}

__device__ void prep_weights_layer(const Params& p, int l, float* lds, int G) {
  unsigned char* ws = p.ws;
  prep_weight(p.in[2] + (size_t)l * D * INW, p.in[1] + l * D, (u16*)(ws + WS_WIN), D, INW, INP, lds, blockIdx.x, G);
  prep_weight(p.in[18] + (size_t)l * D * D, nullptr, (u16*)(ws + WS_WOUT), D, D, D, lds, blockIdx.x, G);
  prep_weight(p.in[21] + (size_t)l * D * DFF, p.in[20] + l * D, (u16*)(ws + WS_WF1), D, DFF, DFF, lds, blockIdx.x, G);
  prep_weight(p.in[22] + (size_t)l * DFF * D, nullptr, (u16*)(ws + WS_WF2), DFF, D, D, lds, blockIdx.x, G);
}

__device__ void row_phase(const float* __restrict__ xold, const u16* __restrict__ y, const float* __restrict__ gain,
                          float* __restrict__ xnew, u16* __restrict__ hn, int G) {
  const int tid = opaque_tid(); const int lane = tid & 63, wave = tid >> 6;
  for (int row = blockIdx.x * 8 + wave; row < M; row += G * 8) {
    float4 xv[4];
#pragma unroll
    for (int j = 0; j < 4; ++j) xv[j] = *(const float4*)(xold + (size_t)row * D + j * 256 + lane * 4);
    if (y) {
      float4 yv[4];
      float ss = 0.f;
#pragma unroll
      for (int j = 0; j < 4; ++j) {
        const uint2 yr = *(const uint2*)(y + (size_t)row * D + j * 256 + lane * 4);
        yv[j].x = __uint_as_float(yr.x << 16); yv[j].y = __uint_as_float(yr.x & 0xffff0000u);
        yv[j].z = __uint_as_float(yr.y << 16); yv[j].w = __uint_as_float(yr.y & 0xffff0000u);
        ss += yv[j].x * yv[j].x + yv[j].y * yv[j].y + yv[j].z * yv[j].z + yv[j].w * yv[j].w;
      }
      ss = wsum_shfl(ss);
      const float rs = rsqrtf(ss * (1.f / D) + EPS);
#pragma unroll
      for (int j = 0; j < 4; ++j) {
        const float4 g = *(const float4*)(gain + j * 256 + lane * 4);
        xv[j].x += yv[j].x * rs * g.x; xv[j].y += yv[j].y * rs * g.y;
        xv[j].z += yv[j].z * rs * g.z; xv[j].w += yv[j].w * rs * g.w;
      }
    }
    if (xnew) {
#pragma unroll
      for (int j = 0; j < 4; ++j) *(float4*)(xnew + (size_t)row * D + j * 256 + lane * 4) = xv[j];
    }
    if (hn) {
      float ss = 0.f;
#pragma unroll
      for (int j = 0; j < 4; ++j) ss += xv[j].x * xv[j].x + xv[j].y * xv[j].y + xv[j].z * xv[j].z + xv[j].w * xv[j].w;
      ss = wsum_shfl(ss);
      const float rs = rsqrtf(ss * (1.f / D) + EPS);
#pragma unroll
      for (int j = 0; j < 4; ++j) {
        uint2 o;
        o.x = pack2(xv[j].x * rs, xv[j].y * rs);
        o.y = pack2(xv[j].z * rs, xv[j].w * rs);
        *(uint2*)(hn + (size_t)row * D + j * 256 + lane * 4) = o;
      }
    }
  }
}

constexpr int EPI_BF16 = 0, EPI_RELU2 = 1, EPI_F32 = 2;
constexpr int GBM = 256, GBN = 128, GBK = 64, GLD = 64;
template <int EPI>
__device__ void gemm_phase(const u16* __restrict__ A, const u16* __restrict__ Bt, void* __restrict__ Cv,
                           int N, int K, int ldc, unsigned char* ldsraw, int G) {
  u16* As = (u16*)ldsraw;
  u16* Bs = As + 2 * GBM * GLD;
  const int tid = opaque_tid(), lane = tid & 63, wave = tid >> 6;
  const int wm = wave >> 1, wn = wave & 1;
  const int l15 = lane & 15, g4 = lane >> 4;
  const int ntn = (N + GBN - 1) / GBN, ntm = M / GBM;
  const int nk = K / GBK;
  const bool swz = (G == 256) && (ntn != 32);
  const int t_begin = swz ? (int)(blockIdx.x >> 3) : (int)blockIdx.x;
  const int t_step = swz ? 32 : G;
  const int t_end = swz ? (ntm / 8) * ntn : ntm * ntn;
  const u16* Ag0 = A; const u16* Bg = Bt; bool pre = false;
  for (int tile = t_begin; tile < t_end; tile += t_step) {
    int tn = tile % ntn, tm = tile / ntn;
    if (swz) tm = (blockIdx.x & 7) + 8 * tm;
    const int m0 = tm * GBM, n0 = tn * GBN;
    f32x4 acc[4][4];
#pragma unroll
    for (int i = 0; i < 4; ++i)
#pragma unroll
      for (int j = 0; j < 4; ++j) acc[i][j] = (f32x4){0.f, 0.f, 0.f, 0.f};
    const int ar0 = tid >> 3, acc4 = tid & 7;
    const int ssw = (acc4 ^ ((ar0 >> 1) & 7)) * 8;
    const int fx = (l15 >> 1) & 7;
    if (!pre) { Ag0 = A + (size_t)(m0 + ar0) * K + ssw; Bg = Bt + (size_t)(n0 + ar0) * K + ssw; }
    const size_t r64 = (size_t)64 * K;
    constexpr int STG = (GBM + GBN) * GLD;
    const unsigned lw0 = (unsigned)__builtin_amdgcn_readfirstlane((int)(unsigned)(uintptr_t)(As + wave * 8 * GLD));
#define GLDS(st_, kt_) { const int kk_ = ((kt_) < nk ? (kt_) : nk - 1) * GBK; const unsigned d_ = lw0 + (unsigned)(st_) * (STG * 2); \
      glds16(Ag0 + kk_, d_); glds16(Ag0 + r64 + kk_, d_ + 64 * GLD * 2); glds16(Ag0 + 2 * r64 + kk_, d_ + 128 * GLD * 2); glds16(Ag0 + 3 * r64 + kk_, d_ + 192 * GLD * 2); \
      glds16(Bg + kk_, d_ + GBM * GLD * 2); glds16(Bg + r64 + kk_, d_ + (GBM + 64) * GLD * 2); }
    if (!pre) { GLDS(0, 0); GLDS(1, 1); }
    int st = 0;
    for (int kt = 0; kt < nk; ++kt) {
      if (kt == 0) asm volatile("s_waitcnt vmcnt(0)" ::: "memory");
      else asm volatile("s_waitcnt vmcnt(6)" ::: "memory");
      lds_barrier();
      const int st2 = (st >= 1) ? st - 1 : 2;
      GLDS(st2, kt + 2);
      const u16* Asx = As + st * STG;
      const u16* Bsx = Asx + GBM * GLD;
#pragma unroll
      for (int ks = 0; ks < 2; ++ks) {
        const int fsw = ((ks * 4 + g4) ^ fx) * 8;
        bf16x8 bfr[4];
#pragma unroll
        for (int jx = 0; jx < 4; ++jx) bfr[jx] = *(const bf16x8*)(Bsx + (wn * 64 + jx * 16 + l15) * GLD + fsw);
#pragma unroll
        for (int ix = 0; ix < 4; ++ix) {
          const bf16x8 af = *(const bf16x8*)(Asx + (wm * 64 + ix * 16 + l15) * GLD + fsw);
#pragma unroll
          for (int jx = 0; jx < 4; ++jx)
            acc[ix][jx] = __builtin_amdgcn_mfma_f32_16x16x32_bf16(af, bfr[jx], acc[ix][jx], 0, 0, 0);
        }
      }
      st = (st == 2) ? 0 : st + 1;
    }
    asm volatile("s_waitcnt vmcnt(0)" ::: "memory");
    lds_barrier();
    {
      const int ntile = tile + t_step;
      pre = ntile < t_end;
      if (pre) {
        int tn2 = ntile % ntn, tm2 = ntile / ntn;
        if (swz) tm2 = (blockIdx.x & 7) + 8 * tm2;
        Ag0 = A + (size_t)(tm2 * GBM + ar0) * K + ssw;
        Bg = Bt + (size_t)(tn2 * GBN + ar0) * K + ssw;
        GLDS(0, 0);
        GLDS(1, 1);
      }
    }
#undef GLDS
#pragma unroll
    for (int i = 0; i < 4; ++i) {
#pragma unroll
      for (int r = 0; r < 4; ++r) {
        const int m = m0 + wm * 64 + i * 16 + g4 * 4 + r;
        const int nb = n0 + wn * 64 + l15;
        if (EPI == EPI_F32) {
          float* cp = (float*)Cv + (size_t)m * ldc + nb;
#pragma unroll
          for (int j = 0; j < 4; ++j) if (nb + j * 16 < N) cp[j * 16] = acc[i][j][r];
        } else {
          u16* cp = (u16*)Cv + (size_t)m * ldc + nb;
#pragma unroll
          for (int j = 0; j < 4; ++j) {
            float v = acc[i][j][r];
            if (EPI == EPI_RELU2) { v = fmaxf(v, 0.f); v = v * v; }
            if (nb + j * 16 < N) cp[j * 16] = f2bf(v);
          }
        }
      }
      __builtin_amdgcn_sched_barrier(0);
    }
  }
}

__device__ void rwprep_items(const Params& p, int l, unsigned char* ldsraw, int it_begin, int it_end, int it_step) {
  float* codes = (float*)ldsraw;
  const u16* proj = (const u16*)(p.ws + WS_PROJ);
  u32* rwp = (u32*)(p.ws + WS_RWP);
  u16* vy = (u16*)(p.ws + WS_VY);
  const float* mu = p.in[4] + l * 1280;
  const float* w0 = p.in[5] + l * 384;
  const float* w_up = p.in[6] + l * 32 * 384;
  const float* a0 = p.in[7] + l * 384;
  const float* a_up = p.in[8] + l * 32 * 384;
  const float* k_k = p.in[10] + l * 384;
  const float* k_a = p.in[11] + l * 384;
  const float* r_k = p.in[12] + l * 384;
  float* bon = (float*)(p.ws + WS_CTRL + 65536);
  const int tid = opaque_tid();
  for (int it = it_begin; it < it_end; it += it_step) {
    const int tok0 = it * 4;
    if (tid < 256) {
      const int tt = tid >> 6, j = tid & 63;
      const int tok = tok0 + tt;
      const int col = 1152 + j;
      const float pc = bf2f(proj[(size_t)tok * INW + RW0 + col]);
      const float pp = (tok % T == 0) ? 0.f : bf2f(proj[(size_t)(tok - 1) * INW + RW0 + col]);
      float s = pc + (pp - pc) * mu[col];
      if (j < 32) { const float e2 = __expf(2.f * s); s = 1.f - 2.f / (e2 + 1.f); }
      codes[tt * 64 + j] = s;
    }
    __syncthreads();
    if (tid < 384) {
      const int c = tid;
      float aw[4], aa[4];
      float pr_[5], pk_[5], pv_[5];
#pragma unroll
      for (int tt = 0; tt < 4; ++tt) { aw[tt] = 0.f; aa[tt] = 0.f; }
#pragma unroll
      for (int tt = 0; tt < 5; ++tt) {
        const int tok = tok0 + tt - 1;
        const bool ok = (tt > 0) || (tok0 % T != 0);
        const u16* pq = proj + (size_t)(ok ? tok : tok0) * INW + RW0;
        pr_[tt] = ok ? bf2f(pq[c]) : 0.f; pk_[tt] = ok ? bf2f(pq[384 + c]) : 0.f; pv_[tt] = ok ? bf2f(pq[768 + c]) : 0.f;
      }
#pragma unroll 4
      for (int j = 0; j < 32; ++j) {
        const float wu = w_up[j * 384 + c], au = a_up[j * 384 + c];
#pragma unroll
        for (int tt = 0; tt < 4; ++tt) {
          aw[tt] += codes[tt * 64 + j] * wu;
          aa[tt] += codes[tt * 64 + 32 + j] * au;
        }
      }
      const float mur = mu[c], muk = mu[384 + c], muv = mu[768 + c];
      const float w0c = w0[c], a0c = a0[c], kkc = k_k[c], kac = k_a[c], rkc = r_k[c];
#pragma unroll
      for (int tt = 0; tt < 4; ++tt) {
        const int tok = tok0 + tt;
        float r = pr_[tt + 1], k = pk_[tt + 1], v = pv_[tt + 1];
        const float r1 = pr_[tt], k1 = pk_[tt], v1 = pv_[tt];
        r += (r1 - r) * mur; k += (k1 - k) * muk; v += (v1 - v) * muv;
        const float xw = w0c + aw[tt];
        const float lw = -softplus_f(-xw) - 0.5f;
        const float dec = __expf(-__expf(lw));
        const float xa = a0c + aa[tt];
        const float asig = 1.f / (1.f + __expf(-xa));
        const float kkr = k * kkc;
        const float ssum = wsum_u(kkr * kkr);
        const float kk = kkr * rsqrtf(fmaxf(ssum, 1e-12f));
        const float kmod = k * (1.f + (asig - 1.f) * kac);
        const size_t o = ((size_t)tok * 384 + c) * 3;
        rwp[o] = __float_as_uint(dec);
        rwp[o + 1] = pack2(kk, kk * asig);
        rwp[o + 2] = pack2(kmod, r);
        const float bsum = wsum_u(r * kmod * rkc);
        if ((tid & 63) == 0) bon[(size_t)tok * 6 + (tid >> 6)] = bsum;
        vy[(size_t)tok * 384 + c] = f2bf(v);
      }
    }
    __syncthreads();
  }
}

constexpr int TC = 8;
constexpr int PRF = 592;
constexpr int CHF = 4 * PRF + TC * 16;
__device__ __forceinline__ float rowsum16(float v) {
  v += dppx<0xB1>(v);
  v += dppx<0x4E>(v);
  v += dppx<0x141>(v);
  v += dppx<0x128>(v);
  return v;
}
__device__ __forceinline__ float dot4(float a0, float a1, float a2, float a3, const float4& b) {
  return fmaf(a1, b.y, a0 * b.x) + fmaf(a3, b.w, a2 * b.z);
}
__device__ void rwscan_item(const Params& p, int l, int item, unsigned char* ldsraw) {
  float* lp = (float*)ldsraw;
  const u32* rwp = (const u32*)(p.ws + WS_RWP);
  const int tid = opaque_tid(), lane = tid & 63, wave = tid >> 6;
  const int bh = item >> 2, q4 = item & 3;
  const int b = bh / 6, h = bh % 6;
  const size_t tokb = (size_t)b * T;
  const int cg = lane & 15, rsel = lane >> 4;
  const int nch = T / TC;
  if (wave >= 4) {
    const int j = wave - 4;
    const u32* src = rwp + ((tokb + 2 * j) * 384 + h * 64 + lane) * 3;
    const u16* srcv = (const u16*)(p.ws + WS_VY) + (tokb + 2 * j + ((lane >> 4) & 1)) * 384 + h * 64 + q4 * 16 + (lane & 15);
    u32 S0[6], S1[6], S2[6], S3[6]; u16 V0, V1, V2, V3;
    int ready_chunk = -1;
    const u32* prep_done = (const u32*)(p.ws + WS_CTRL) + 512 + l * 256;
    u32* scan_done = (u32*)(p.ws + WS_CTRL) + 1024 + l * 256;
#define LD_SET(S, V, chunk) { \
      const int cc_ = (chunk) < nch ? (chunk) : nch - 1; \
      if ((cc_ & 7) == 0 && cc_ > ready_chunk) { \
          \
        const u32* rc_ = prep_done + b * 64 + (cc_ >> 3); \
        while (__hip_atomic_load(rc_, __ATOMIC_RELAXED, __HIP_MEMORY_SCOPE_AGENT) < 4u) __builtin_amdgcn_s_sleep(4); \
        __builtin_amdgcn_fence(__ATOMIC_ACQUIRE, "agent"); \
        asm volatile("s_waitcnt vmcnt(0)" ::: "memory"); \
        ready_chunk = cc_; \
      } \
      const size_t go = (size_t)cc_ * TC * 384 * 3; \
      S[0] = src[go]; S[1] = src[go + 1]; S[2] = src[go + 2]; S[3] = src[go + 1152]; S[4] = src[go + 1153]; S[5] = src[go + 1154]; \
      V = srcv[(size_t)cc_ * TC * 384]; }
#define PROC_SET(S, V, buf) { \
      const float w1 = __uint_as_float(S[0]), kk1 = __uint_as_float(S[1] << 16), b1 = __uint_as_float(S[1] & 0xffff0000u); \
      const float km1 = __uint_as_float(S[2] << 16), r1 = __uint_as_float(S[2] & 0xffff0000u); \
      const float w2 = __uint_as_float(S[3]), kk2 = __uint_as_float(S[4] << 16), b2 = __uint_as_float(S[4] & 0xffff0000u); \
      const float km2 = __uint_as_float(S[5] << 16), r2 = __uint_as_float(S[5] & 0xffff0000u); \
      const float U0 = w1 * w2, U1 = b1 * w2, U2 = km1 * w2; \
      float* pb = lp + (buf) * CHF + j * PRF; \
      pb[lane] = kk1; pb[64 + lane] = w1 * kk2; pb[128 + lane] = w1 * r1; pb[192 + lane] = U0 * r2; \
      pb[256 + lane] = U0; pb[320 + lane] = U1; pb[384 + lane] = U2; pb[448 + lane] = b2; pb[512 + lane] = km2; \
      const float c1 = wsum_dpp63(b1 * kk2), c2 = wsum_dpp63(km1 * kk2), c3 = wsum_dpp63(b1 * r1), c4 = wsum_dpp63(km1 * r1); \
      const float c5 = wsum_dpp63(U1 * r2), c6 = wsum_dpp63(U2 * r2), c7 = wsum_dpp63(b2 * r2), c8 = wsum_dpp63(km2 * r2); \
      if (lane == 63) { *(float4*)(pb + 576) = make_float4(c1, c2, c3, c4); *(float4*)(pb + 580) = make_float4(c5, c6, c7, c8); } \
      if (lane < 32) lp[(buf) * CHF + 4 * PRF + (2 * j + (lane >> 4)) * 16 + (lane & 15)] = bf2f(V); }
    LD_SET(S0, V0, 0);
    PROC_SET(S0, V0, 0);
    LD_SET(S1, V1, 1);
    LD_SET(S2, V2, 2);
    LD_SET(S3, V3, 3);
    LD_SET(S0, V0, 4);
    lds_barrier();
    for (int ch = 0; ch < nch; ch += 4) {
      PROC_SET(S1, V1, 1); LD_SET(S1, V1, ch + 5); lds_barrier();
      PROC_SET(S2, V2, 0); LD_SET(S2, V2, ch + 6); lds_barrier();
      PROC_SET(S3, V3, 1); LD_SET(S3, V3, ch + 7); lds_barrier();
      PROC_SET(S0, V0, 0); LD_SET(S0, V0, ch + 8); lds_barrier();
      if (((ch + 4) & 7) == 0 && ch + 4 >= 16 && wave == 4 && lane == 0) {
        __hip_atomic_fetch_add(scan_done + b * 64 + ((ch + 4) >> 3) - 2, 1u, __ATOMIC_RELAXED, __HIP_MEMORY_SCOPE_AGENT);
      }
    }
#undef LD_SET
#undef PROC_SET
  } else {
    typedef float f32x2 __attribute__((ext_vector_type(2)));
    f32x2 sa = {0.f, 0.f}, sb = {0.f, 0.f};
    const int row = q4 * 16 + wave * 4 + rsel;
    const bool bit0 = (lane & 1) != 0, bit1 = (lane & 2) != 0, isy1 = (cg & 3) == 2;
    u16* yl = (u16*)(p.ws + WS_ABUF) + (tokb + 2 * (cg >> 2) + (cg & 1)) * D + 384 + h * 64 + row;
    lds_barrier();
    for (int ch = 0; ch < nch; ++ch) {
      const float* cb = lp + (ch & 1) * CHF;
      float yv[4];
#pragma unroll
      for (int j = 0; j < 4; ++j) {
        const f32x2* pb = (const f32x2*)(cb + j * PRF + cg * 4);
#define LDV(k, lo, hi) const f32x2 lo = pb[(k) * 32], hi = pb[(k) * 32 + 1];
        LDV(0, A1a, A1b) LDV(1, A2a, A2b) LDV(2, A3a, A3b) LDV(3, A4a, A4b)
        LDV(4, U0a, U0b) LDV(5, U1a, U1b) LDV(6, U2a, U2b) LDV(7, U3a, U3b) LDV(8, U4a, U4b)
#undef LDV
        const float4 ca = *(const float4*)(cb + j * PRF + 576), cc = *(const float4*)(cb + j * PRF + 580);
        const float v1 = cb[4 * PRF + (2 * j) * 16 + wave * 4 + rsel];
        const float v2 = cb[4 * PRF + (2 * j + 1) * 16 + wave * 4 + rsel];
        f32x2 t1 = sa * A1a + sb * A1b, t2 = sa * A2a + sb * A2b, t3 = sa * A3a + sb * A3b, t4 = sa * A4a + sb * A4b;
        const float p1 = t1.x + t1.y, p2 = t2.x + t2.y, p3 = t3.x + t3.y, p4 = t4.x + t4.y;
        const float u12 = (bit0 ? p2 : p1) + dppx<0xB1>(bit0 ? p1 : p2);
        const float u34 = (bit0 ? p4 : p3) + dppx<0xB1>(bit0 ? p3 : p4);
        float wq = (bit1 ? u34 : u12) + dppx<0x4E>(bit1 ? u12 : u34);
        wq += dppx<0x124>(wq);
        wq += dppx<0x128>(wq);
        const float d1 = -dppx<0x00>(wq);
        const float d2 = -(dppx<0x55>(wq) + d1 * ca.x + v1 * ca.y);
        const float e1 = isy1 ? ca.z : cc.x, e2 = isy1 ? ca.w : cc.y, e3 = isy1 ? 0.f : cc.z, e4 = isy1 ? 0.f : cc.w;
        yv[j] = wq + d1 * e1 + v1 * e2 + d2 * e3 + v2 * e4;
        sa = sa * U0a + d1 * U1a + v1 * U2a + d2 * U3a + v2 * U4a;
        sb = sb * U0b + d1 * U1b + v1 * U2b + d2 * U3b + v2 * U4b;
      }
      {
        float ym = 0.f;
#pragma unroll
        for (int jj = 0; jj < 4; ++jj) ym = ((cg >> 2) == jj) ? yv[jj] : ym;
        if ((cg & 2) != 0) __hip_atomic_store(yl, f2bf(ym), __ATOMIC_RELAXED, __HIP_MEMORY_SCOPE_AGENT);
        yl += (size_t)TC * D;
      }
      if ((ch & 7) == 7) asm volatile("s_waitcnt vmcnt(8)" ::: "memory");
      lds_barrier();
    }
  }
  __syncthreads();
  if (tid == 256) __hip_atomic_fetch_add((u32*)(p.ws + WS_CTRL) + 1024 + l * 256 + b * 64 + 63, 1u, __ATOMIC_RELAXED, __HIP_MEMORY_SCOPE_AGENT);
}

constexpr int KLD = 72;
__device__ void sbattn_item(const Params& p, int l, int item, unsigned char* ldsraw) {
  u16* Ks = (u16*)ldsraw;
  u16* Vt = Ks + 64 * KLD;
  const u16* proj = (const u16*)(p.ws + WS_PROJ);
  u16* mix = (u16*)(p.ws + WS_ABUF);
  const float* ng = p.in[3] + l * 384;
  const int tid = opaque_tid(), lane = tid & 63, wave = tid >> 6;
  const int l15 = lane & 15, g4 = lane >> 4;
  const int bh = item % 24, qb = 31 - item / 24;
  const int b = bh / 6, h = bh % 6;
  const size_t tokb = (size_t)b * T;
  const int Q0 = qb * 128, q0 = Q0 + wave * 16;
  const int qi = q0 + l15;
  bf16x8 bq[2];
#pragma unroll
  for (int ks = 0; ks < 2; ++ks)
    bq[ks] = *(const bf16x8*)(proj + (tokb + qi) * INW + SBQ + h * 64 + ks * 32 + g4 * 8);
  bf16x8 P0, P1, ONES;
#pragma unroll
  for (int i = 0; i < 8; ++i) {
    const int jj = (i < 4) ? (4 * g4 + i) : (16 + 4 * g4 + (i - 4));
    P0[i] = (jj > l15) ? (short)0x3F80 : (short)0;
    P1[i] = (jj > 16 + l15) ? (short)0x3F80 : (short)0;
    ONES[i] = (short)0x3F80;
  }
  f32x4 ot[4];
#pragma unroll
  for (int i = 0; i < 4; ++i) ot[i] = (f32x4){0.f, 0.f, 0.f, 0.f};
  float carry = 0.f;
  const float SC = 0.125f * LOG2E;
  const int kb_hi = 2 * qb + 1;
  const int kb_diag = q0 >> 6;
  for (int kb = kb_hi; kb >= 0; --kb) {
    if (__syncthreads_and(carry < -151.f)) break;
    {
      const int key = tid >> 3, ch = tid & 7;
      const u16* src = proj + (tokb + kb * 64 + key) * INW + h * 64 + ch * 8;
      const uint4 kv = *(const uint4*)(src + SBK);
      const uint4 vv = *(const uint4*)(src + SBV);
      *(uint4*)(Ks + key * KLD + ch * 8) = kv;
      const u32 w[4] = {vv.x, vv.y, vv.z, vv.w};
#pragma unroll
      for (int i = 0; i < 4; ++i) {
        Vt[(ch * 8 + 2 * i) * KLD + key] = (u16)(w[i] & 0xffffu);
        Vt[(ch * 8 + 2 * i + 1) * KLD + key] = (u16)(w[i] >> 16);
      }
    }
    __syncthreads();
    if (kb > kb_diag) continue;
    f32x4 st[4];
#pragma unroll
    for (int f = 0; f < 4; ++f) {
      st[f] = (f32x4){0.f, 0.f, 0.f, 0.f};
#pragma unroll
      for (int ks = 0; ks < 2; ++ks) {
        const bf16x8 ak = *(const bf16x8*)(Ks + (f * 16 + l15) * KLD + ks * 32 + g4 * 8);
        st[f] = __builtin_amdgcn_mfma_f32_16x16x32_bf16(ak, bq[ks], st[f], 0, 0, 0);
      }
    }
    float e0[4][4];
    bf16x8 lb[2];
    const bool diag = (kb == kb_diag);
#pragma unroll
    for (int f = 0; f < 4; ++f)
#pragma unroll
      for (int j = 0; j < 4; ++j) {
        const float t = st[f][j] * SC;
        float lv = -(fmaxf(t, 0.f) + __builtin_amdgcn_logf(1.f + __builtin_amdgcn_exp2f(-fabsf(t))));
        e0[f][j] = t + lv;
        if (diag) { const int key = kb * 64 + 16 * f + 4 * g4 + j; if (key >= qi) lv = 0.f; }
        lb[f >> 1][(f & 1) * 4 + j] = (short)f2bf(lv);
      }
    const f32x4 cv = (f32x4){carry, carry, carry, carry};
    f32x4 tot = __builtin_amdgcn_mfma_f32_16x16x32_bf16(ONES, lb[0], cv, 0, 0, 0);
    tot = __builtin_amdgcn_mfma_f32_16x16x32_bf16(ONES, lb[1], tot, 0, 0, 0);
    bf16x8 wb[2];
#pragma unroll
    for (int f = 0; f < 4; ++f) {
      f32x4 bt;
      if (f == 0) { bt = __builtin_amdgcn_mfma_f32_16x16x32_bf16(P0, lb[0], cv, 0, 0, 0); bt = __builtin_amdgcn_mfma_f32_16x16x32_bf16(ONES, lb[1], bt, 0, 0, 0); }
      else if (f == 1) { bt = __builtin_amdgcn_mfma_f32_16x16x32_bf16(P1, lb[0], cv, 0, 0, 0); bt = __builtin_amdgcn_mfma_f32_16x16x32_bf16(ONES, lb[1], bt, 0, 0, 0); }
      else if (f == 2) bt = __builtin_amdgcn_mfma_f32_16x16x32_bf16(P0, lb[1], cv, 0, 0, 0);
      else bt = __builtin_amdgcn_mfma_f32_16x16x32_bf16(P1, lb[1], cv, 0, 0, 0);
#pragma unroll
      for (int j = 0; j < 4; ++j) {
        float w = __builtin_amdgcn_exp2f(e0[f][j] + bt[j]);
        if (diag) { const int key = kb * 64 + 16 * f + 4 * g4 + j; if (key >= qi) w = 0.f; }
        wb[f >> 1][(f & 1) * 4 + j] = (short)f2bf(w);
      }
    }
#pragma unroll
    for (int df = 0; df < 4; ++df)
#pragma unroll
      for (int k2 = 0; k2 < 2; ++k2) {
        const u16* vp = Vt + (df * 16 + l15) * KLD + k2 * 32 + 4 * g4;
        const uint2 lo = *(const uint2*)(vp);
        const uint2 hi = *(const uint2*)(vp + 16);
        bf16x8 av;
        av[0] = (short)(lo.x & 0xffff); av[1] = (short)(lo.x >> 16); av[2] = (short)(lo.y & 0xffff); av[3] = (short)(lo.y >> 16);
        av[4] = (short)(hi.x & 0xffff); av[5] = (short)(hi.x >> 16); av[6] = (short)(hi.y & 0xffff); av[7] = (short)(hi.y >> 16);
        ot[df] = __builtin_amdgcn_mfma_f32_16x16x32_bf16(av, wb[k2], ot[df], 0, 0, 0);
      }
    carry = tot[0];
  }
  float ss = 0.f;
#pragma unroll
  for (int df = 0; df < 4; ++df)
#pragma unroll
    for (int j = 0; j < 4; ++j) ss += ot[df][j] * ot[df][j];
  ss += __shfl_xor(ss, 16, 64);
  ss += __shfl_xor(ss, 32, 64);
  const float rs = rsqrtf(ss * (1.f / 64.f) + EPS);
#pragma unroll
  for (int df = 0; df < 4; ++df) {
    const int d = 16 * df + 4 * g4;
    const float4 gg = *(const float4*)(ng + h * 64 + d);
    uint2 o;
    o.x = pack2(ot[df][0] * rs * gg.x, ot[df][1] * rs * gg.y);
    o.y = pack2(ot[df][2] * rs * gg.z, ot[df][3] * rs * gg.w);
    *(uint2*)(mix + (tokb + qi) * D + h * 64 + d) = o;
  }
  __syncthreads();
}

__device__ void gla_load(const Params& p, int l, int b, int h, int c, float* qs, float* ks, float* vs, float* bc, float* gds) {
  const u16* proj = (const u16*)(p.ws + WS_PROJ);
  const float* gate_up = p.in[15] + l * 16 * 128;
  const float* gate_b = p.in[16] + l * 128;
  const int tid = opaque_tid();
  const size_t tok0 = (size_t)b * T + c * 64;
  const float qsc = 0.17677669529663687f;
  for (int e = tid; e < 64 * 32; e += NT) {
    const int t = e >> 5, k = e & 31;
    const u16* pr = proj + (tok0 + t) * INW + GL0;
    qs[e] = bf2f(pr[h * 32 + k]) * qsc;
    ks[e] = bf2f(pr[128 + h * 32 + k]);
  }
  for (int e = tid; e < 64 * 64; e += NT) {
    const int t = e >> 6, v = e & 63;
    vs[e] = bf2f(proj[(tok0 + t) * INW + GL0 + 256 + h * 64 + v]);
  }
  for (int e = tid; e < 64 * 16; e += NT) {
    const int t = e >> 4, j = e & 15;
    gds[e] = bf2f(proj[(tok0 + t) * INW + GL0 + 512 + j]);
  }
  __syncthreads();
  for (int e = tid; e < 64 * 32; e += NT) {
    const int t = e >> 5, k = e & 31;
    float x = gate_b[h * 32 + k];
#pragma unroll
    for (int j = 0; j < 16; ++j) x += gds[t * 16 + j] * gate_up[j * 128 + h * 32 + k];
    bc[e] = -softplus_f(-x) * (1.f / 16.f);
  }
  __syncthreads();
  {
    const int k = tid & 31, seg = (tid >> 5) & 7;
    float v[8];
    if (tid < 256) {
      float a = 0.f;
#pragma unroll
      for (int i = 0; i < 8; ++i) { a += bc[(seg * 8 + i) * 32 + k]; v[i] = a; }
#pragma unroll
      for (int i = 0; i < 8; ++i) bc[(seg * 8 + i) * 32 + k] = v[i];
    }
    __syncthreads();
    float off = 0.f;
    if (tid < 256) for (int s2 = 0; s2 < seg; ++s2) off += bc[(s2 * 8 + 7) * 32 + k];
    __syncthreads();
    if (tid < 256) {
#pragma unroll
      for (int i = 0; i < 8; ++i) bc[(seg * 8 + i) * 32 + k] = v[i] + off;
    }
  }
  __syncthreads();
}

__device__ void gla_passA_item(const Params& p, int l, int item, unsigned char* ldsraw) {
  float* qs = (float*)ldsraw; float* ks = qs + 2048; float* vs = ks + 2048; float* bc = vs + 4096;
  float* sc = bc + 2048; float* S0 = sc + 4096; float* gds = S0 + 2048;
  const int c = item & 63, bh = item >> 6, b = bh >> 2, h = bh & 3;
  gla_load(p, l, b, h, c, qs, ks, vs, bc, gds);
  const int tid = opaque_tid();
  float* kd = sc;
  for (int e = tid; e < 2048; e += NT) {
    const int k = e & 31;
    kd[e] = ks[e] * __expf(bc[63 * 32 + k] - bc[e]);
  }
  __syncthreads();
  float* gS = (float*)(p.ws + WS_GLAS) + (size_t)item * 2048;
  float* gD = (float*)(p.ws + WS_GLAD) + (size_t)item * 32;
  for (int e = tid; e < 2048; e += NT) {
    const int k = e >> 6, v = e & 63;
    float a = 0.f;
#pragma unroll 8
    for (int s = 0; s < 64; ++s) a += kd[s * 32 + k] * vs[s * 64 + v];
    gS[e] = a;
  }
  if (tid < 32) gD[tid] = __expf(bc[63 * 32 + tid]);
  __syncthreads();
}

__device__ void gla_passC_item(const Params& p, int l, int item, unsigned char* ldsraw) {
  float* qs = (float*)ldsraw; float* ks = qs + 2048; float* vs = ks + 2048; float* bc = vs + 4096;
  float* sc = bc + 2048; float* S0 = sc + 4096; float* gds = S0 + 2048;
  const int c = item & 63, bh = item >> 6, b = bh >> 2, h = bh & 3;
  gla_load(p, l, b, h, c, qs, ks, vs, bc, gds);
  const int tid = opaque_tid();
  const u16* proj = (const u16*)(p.ws + WS_PROJ);
  u16* mix = (u16*)(p.ws + WS_ABUF);
  const float* norm_g = p.in[17] + l * 256;
  const bool wide = __syncthreads_or(tid < 32 && bc[63 * 32 + tid] < -60.f) != 0;
  if (!wide) {
    float qv[4], kv[4];
#pragma unroll
    for (int i = 0; i < 4; ++i) {
      const int e = tid + NT * i, k = e & 31;
      const float m = bc[32 * 32 + k];
      qv[i] = qs[e] * __expf(bc[e] - m);
      kv[i] = ks[e] * __expf(m - bc[e]);
    }
    __syncthreads();
    float* QpT = S0;
    float* KpT = ks;
#pragma unroll
    for (int i = 0; i < 4; ++i) {
      const int e = tid + NT * i, t = e >> 5, k = e & 31;
      QpT[k * 64 + t] = qv[i];
      KpT[k * 64 + t] = kv[i];
    }
    __syncthreads();
    {
      const int t0 = (tid >> 4) * 2, s0 = (tid & 15) * 4;
      float a0[4] = {0.f, 0.f, 0.f, 0.f}, a1[4] = {0.f, 0.f, 0.f, 0.f};
#pragma unroll 8
      for (int k = 0; k < 32; ++k) {
        const float2 q2 = *(const float2*)(QpT + k * 64 + t0);
        const float4 k4 = *(const float4*)(KpT + k * 64 + s0);
        a0[0] += q2.x * k4.x; a0[1] += q2.x * k4.y; a0[2] += q2.x * k4.z; a0[3] += q2.x * k4.w;
        a1[0] += q2.y * k4.x; a1[1] += q2.y * k4.y; a1[2] += q2.y * k4.z; a1[3] += q2.y * k4.w;
      }
#pragma unroll
      for (int jx = 0; jx < 4; ++jx) {
        sc[t0 * 64 + s0 + jx] = (s0 + jx <= t0) ? a0[jx] : 0.f;
        sc[(t0 + 1) * 64 + s0 + jx] = (s0 + jx <= t0 + 1) ? a1[jx] : 0.f;
      }
    }
  } else {
    for (int e = tid; e < 4096; e += NT) {
      const int t = e >> 6, s = e & 63;
      float a = 0.f;
      if (s <= t) {
#pragma unroll 4
        for (int k = 0; k < 32; ++k) a += qs[t * 32 + k] * ks[s * 32 + k] * __expf(bc[t * 32 + k] - bc[s * 32 + k]);
      }
      sc[e] = a;
    }
  }
  __syncthreads();
  {
    const float* gS = (const float*)(p.ws + WS_GLAS) + (size_t)(bh * 64) * 2048;
    const float* gD = (const float*)(p.ws + WS_GLAD) + (size_t)(bh * 64) * 32;
    float a[4] = {0.f, 0.f, 0.f, 0.f};
#pragma unroll 8
    for (int cc = 0; cc < c; ++cc) {
#pragma unroll
      for (int i = 0; i < 4; ++i) {
        const int e = tid + NT * i;
        a[i] = a[i] * gD[cc * 32 + (e >> 6)] + gS[(size_t)cc * 2048 + e];
      }
    }
#pragma unroll
    for (int i = 0; i < 4; ++i) S0[tid + NT * i] = a[i];
  }
  for (int e = tid; e < 2048; e += NT) qs[e] *= __expf(bc[e]);
  __syncthreads();
  {
    const int t = tid >> 3, v0 = (tid & 7) * 8;
    float o[8];
#pragma unroll
    for (int i = 0; i < 8; ++i) o[i] = 0.f;
#pragma unroll 2
    for (int s = 0; s <= t; ++s) {
      const float w = sc[t * 64 + s];
#pragma unroll
      for (int i = 0; i < 8; ++i) o[i] += w * vs[s * 64 + v0 + i];
    }
#pragma unroll 2
    for (int k = 0; k < 32; ++k) {
      const float w = qs[t * 32 + k];
#pragma unroll
      for (int i = 0; i < 8; ++i) o[i] += w * S0[k * 64 + v0 + i];
    }
    float ss = 0.f;
#pragma unroll
    for (int i = 0; i < 8; ++i) ss += o[i] * o[i];
    ss += __shfl_xor(ss, 1, 64); ss += __shfl_xor(ss, 2, 64); ss += __shfl_xor(ss, 4, 64);
    const float rs = rsqrtf(ss * (1.f / 64.f) + EPS);
    const size_t tok = (size_t)b * T + c * 64 + t;
    u32 ow[4];
    float r2[8];
#pragma unroll
    for (int i = 0; i < 8; ++i) {
      const float g = bf2f(proj[tok * INW + GL0 + 528 + h * 64 + v0 + i]);
      const float sil = g / (1.f + __expf(-g));
      r2[i] = o[i] * rs * norm_g[h * 64 + v0 + i] * sil;
    }
#pragma unroll
    for (int i = 0; i < 4; ++i) ow[i] = pack2(r2[2 * i], r2[2 * i + 1]);
    *(uint4*)(mix + tok * D + 768 + h * 64 + v0) = make_uint4(ow[0], ow[1], ow[2], ow[3]);
  }
  __syncthreads();
}

__device__ void rwfinal_items(const Params& p, int l, unsigned char* ldsraw, int it_begin, int it_end, int it_step, bool stage_gup) {
  float* codes = (float*)ldsraw;
  u16* gul = (u16*)(ldsraw + 4096);
  const u16* proj = (const u16*)(p.ws + WS_PROJ);
  const u32* rwp = (const u32*)(p.ws + WS_RWP);
  const u16* vy = (const u16*)(p.ws + WS_VY);
  u16* mix = (u16*)(p.ws + WS_ABUF);
  const float* mu = p.in[4] + l * 1280;
  const float* g_up = p.in[9] + l * 64 * 384;
  const float* bon = (const float*)(p.ws + WS_CTRL + 65536);
  const float* gn_g = p.in[13] + l * 384;
  const float* gn_b = p.in[14] + l * 384;
  const int tid = opaque_tid();
  if (stage_gup) { for (int e = tid; e < 64 * 384; e += NT) gul[e] = f2bf(g_up[e]); }
  __syncthreads();
  for (int it = it_begin; it < it_end; it += it_step) {
    const int tok0 = it * 8;
    {
      const int tt = tid >> 6, j = tid & 63;
      const int tok = tok0 + tt;
      const int col = 1216 + j;
      const float pc = bf2f(proj[(size_t)tok * INW + RW0 + col]);
      const float pp = (tok % T == 0) ? 0.f : bf2f(proj[(size_t)(tok - 1) * INW + RW0 + col]);
      const float s = pc + (pp - pc) * mu[col];
      codes[tt * 64 + j] = 1.f / (1.f + __expf(-s));
    }
    __syncthreads();
    if (tid < 384) {
      const int c = tid;
      float ag[8], pv[8], py[8], pbn[8];
#pragma unroll
      for (int tt = 0; tt < 8; ++tt) {
        ag[tt] = 0.f;
        pv[tt] = bf2f(vy[(size_t)(tok0 + tt) * 384 + c]);
        py[tt] = bf2f(mix[(size_t)(tok0 + tt) * D + 384 + c]);
        pbn[tt] = bon[(size_t)(tok0 + tt) * 6 + (tid >> 6)];
      }
#pragma unroll 8
      for (int j = 0; j < 64; ++j) {
        const float gu = bf2f(gul[j * 384 + c]);
#pragma unroll
        for (int tt = 0; tt < 8; ++tt) ag[tt] += codes[tt * 64 + j] * gu;
      }
      const float gg = gn_g[c], gb = gn_b[c];
#pragma unroll
      for (int tt = 0; tt < 8; ++tt) {
        const float v = pv[tt], y = py[tt];
        const int tok = tok0 + tt;
        const float mean = wsum_u(y) * (1.f / 64.f);
        const float dv = y - mean;
        const float var = wsum_u(dv * dv) * (1.f / 64.f);
        const float yn = dv * rsqrtf(var + 64e-5f) * gg + gb;
        const float bonus = pbn[tt] * v;
        mix[(size_t)tok * D + 384 + c] = f2bf((yn + bonus) * ag[tt]);
      }
    }
    __syncthreads();
  }
}

__device__ __forceinline__ void fast_grid_barrier(u32* bw, u32 k, int G) {
  asm volatile("s_waitcnt vmcnt(0)" ::: "memory");
  __syncthreads();
  if (threadIdx.x == 0) {
    const u32 x = blockIdx.x & 7u, per = ((u32)G - x + 7u) >> 3;
    u32* A = bw + 16 * x; u32* W = bw + 16 * 8; u32* F = bw + 16 * (9 + x);
    __builtin_amdgcn_fence(__ATOMIC_RELEASE, "agent");
    asm volatile("s_waitcnt vmcnt(0)" ::: "memory");
    const u32 old = __hip_atomic_fetch_add(A, 1u, __ATOMIC_RELAXED, __HIP_MEMORY_SCOPE_AGENT);
    if (old + 1u == per * k) {
      const u32 oldw = __hip_atomic_fetch_add(W, 1u, __ATOMIC_RELAXED, __HIP_MEMORY_SCOPE_AGENT);
      if (oldw + 1u == 8u * k) {
        for (int i = 0; i < 8; ++i) __hip_atomic_store(bw + 16 * (9 + i), k, __ATOMIC_RELAXED, __HIP_MEMORY_SCOPE_AGENT);
      }
    }
    while (__hip_atomic_load(F, __ATOMIC_RELAXED, __HIP_MEMORY_SCOPE_AGENT) < k) __builtin_amdgcn_s_sleep(2);
    __builtin_amdgcn_fence(__ATOMIC_ACQUIRE, "agent");
    asm volatile("s_waitcnt vmcnt(0)" ::: "memory");
  }
  __syncthreads();
}

constexpr int LDS_BYTES = 147456;
#ifndef RES_TEST_ONLY
constexpr int N_SCAN_ITEMS = 96;
constexpr int N_ATT_ITEMS = 768;
constexpr int N_GLA_ITEMS = 1024;
constexpr int N_PREP_ITEMS = M / 16;
constexpr int N_FIN_ITEMS = M / 8;

template <bool COOP>
__global__ void __launch_bounds__(NT, 2) mega(Params p) {
  extern __shared__ __attribute__((aligned(16))) unsigned char lds[];
  int& s_item = *(int*)(lds + LDS_BYTES);
  const int G = gridDim.x;
  unsigned char* ws = p.ws;
  u32* ctr = (u32*)(ws + WS_CTRL);
  u16* abuf = (u16*)(ws + WS_ABUF);
  u16* cbuf = (u16*)(ws + WS_CBUF);
  u16* ffh = (u16*)(ws + WS_FFH);
  u16* proj = (u16*)(ws + WS_PROJ);
  u32 nbar = 0;
#pragma nounroll
  for (int ph = p.phase_lo; ph < p.phase_hi; ++ph) {
    const int l = (ph == 0) ? 0 : (ph - 1) / 9;
    const int kind = (ph == 0) ? 0 : 1 + (ph - 1) % 9;
    for (int rep = 0; rep < (((REPEAT_MASK >> kind) & 1) ? 2 : 1); ++rep) {
    if (rep) __syncthreads();
    switch (kind) {
      case 0:
        if (blockIdx.x == 0) { const int t0 = opaque_tid(); ctr[t0] = 0u; ctr[t0 + 512] = 0u; ctr[t0 + 1024] = 0u; ctr[t0 + 1536] = 0u; }
        prep_weights_layer(p, 0, (float*)lds, G);
        row_phase(p.in[0], nullptr, nullptr, nullptr, abuf, G);
        break;
      case 1:
        gemm_phase<EPI_BF16>(abuf, (const u16*)(ws + WS_WIN), proj, INW, D, INW, lds, G);
        break;
      case 2:
        break;
      case 3: {
#ifndef REP_SCAN
#define REP_SCAN 1
#endif
#ifndef REP_QUEUE
#define REP_QUEUE 1
#endif
        for (int r2 = 0; r2 < REP_SCAN; ++r2) {
        if (G > N_SCAN_ITEMS) {
          if ((int)blockIdx.x < N_SCAN_ITEMS) rwscan_item(p, l, blockIdx.x, lds);
        } else {
          for (int it = blockIdx.x; it < N_SCAN_ITEMS; it += G) rwscan_item(p, l, it, lds);
        }
        }
        bool gul_ready = false;
        for (int r2 = 0; r2 < REP_QUEUE; ++r2)
        for (;;) {
          __syncthreads();
          if (opaque_tid() == 0) s_item = (int)atomicAdd(&ctr[l + 2 * rep + 4 * r2], 1u);
          __syncthreads();
          int it = s_item;
          if (it >= N_PREP_ITEMS + N_ATT_ITEMS + 2 * N_GLA_ITEMS + N_FIN_ITEMS) break;
          if (it >= N_PREP_ITEMS + N_ATT_ITEMS + 2 * N_GLA_ITEMS) {
            const int fi = it - (N_PREP_ITEMS + N_ATT_ITEMS + 2 * N_GLA_ITEMS);
            const int within = fi & 7, rr = fi >> 3, bb = rr & 3, tb = rr >> 2;
            if (opaque_tid() == 0) {
              const u32* sd = ctr + 1024 + l * 256 + bb * 64 + tb;
              while (__hip_atomic_load(sd, __ATOMIC_RELAXED, __HIP_MEMORY_SCOPE_AGENT) < 24u) __builtin_amdgcn_s_sleep(100);
              __builtin_amdgcn_fence(__ATOMIC_ACQUIRE, "agent");
              asm volatile("s_waitcnt vmcnt(0)" ::: "memory");
            }
            __syncthreads();
            const int fit = (bb * T + tb * 64) / 8 + within;
            rwfinal_items(p, l, lds, fit, fit + 1, 1, !gul_ready);
            gul_ready = true;
            continue;
          }
          gul_ready = false;
          if (it < N_PREP_ITEMS) {
            const int within = it & 3, rr = it >> 2, bb = rr & 3, tb = rr >> 2;
            const int pit = (bb * T + tb * 64) / 4 + within * 4;
            rwprep_items(p, l, lds, pit, pit + 4, 1);
            asm volatile("s_waitcnt vmcnt(0)" ::: "memory");
            __syncthreads();
            if (opaque_tid() == 0) {
              __builtin_amdgcn_fence(__ATOMIC_RELEASE, "agent");
              asm volatile("s_waitcnt vmcnt(0)" ::: "memory");
              __hip_atomic_fetch_add(ctr + 512 + l * 256 + bb * 64 + tb, 1u, __ATOMIC_RELAXED, __HIP_MEMORY_SCOPE_AGENT);
            }
            continue;
          }
          it -= N_PREP_ITEMS;
          u32* glaA_done = ctr + 40 + l;
          if (it < N_GLA_ITEMS) {
            gla_passA_item(p, l, it, lds);
            asm volatile("s_waitcnt vmcnt(0)" ::: "memory");
            __syncthreads();
            if (opaque_tid() == 0) {
              __builtin_amdgcn_fence(__ATOMIC_RELEASE, "agent");
              asm volatile("s_waitcnt vmcnt(0)" ::: "memory");
              __hip_atomic_fetch_add(glaA_done, 1u, __ATOMIC_RELAXED, __HIP_MEMORY_SCOPE_AGENT);
            }
          } else if (it < N_GLA_ITEMS + N_ATT_ITEMS) {
            sbattn_item(p, l, it - N_GLA_ITEMS, lds);
          } else {
            if (opaque_tid() == 0) {
              while (__hip_atomic_load(glaA_done, __ATOMIC_RELAXED, __HIP_MEMORY_SCOPE_AGENT) < (u32)N_GLA_ITEMS) __builtin_amdgcn_s_sleep(8);
              __builtin_amdgcn_fence(__ATOMIC_ACQUIRE, "agent");
              asm volatile("s_waitcnt vmcnt(0)" ::: "memory");
            }
            __syncthreads();
            gla_passC_item(p, l, it - N_GLA_ITEMS - N_ATT_ITEMS, lds);
          }
        }
      } break;
      case 4:
        break;
      case 5:
        gemm_phase<EPI_BF16>(abuf, (const u16*)(ws + WS_WOUT), cbuf, D, D, D, lds, G);
        break;
      case 6:
        row_phase(l == 0 ? p.in[0] : p.out, cbuf, p.in[19] + l * D, p.out, abuf, G);
        break;
      case 7:
        gemm_phase<EPI_RELU2>(abuf, (const u16*)(ws + WS_WF1), ffh, DFF, D, DFF, lds, G);
        break;
      case 8:
        gemm_phase<EPI_BF16>(ffh, (const u16*)(ws + WS_WF2), cbuf, D, DFF, D, lds, G);
        break;
      default:
        row_phase(p.out, cbuf, p.in[23] + l * D, p.out, l == 0 ? abuf : nullptr, G);
        if (l == 0) prep_weights_layer(p, 1, (float*)lds, G);
        break;
    }
    }
    if (COOP) {
      if (ph + 1 < p.phase_hi && kind != 2 && kind != 4) {
        if (ph == 0) cg::this_grid().sync();
        else fast_grid_barrier(ctr + 64, ++nbar, G);
      }
    }
  }
}
constexpr int N_PHASES = 19;

extern "C" void kernel_launch(void* const* d_in, const int* in_sizes, int n_in, void* d_out, int out_size,
                              void* d_ws, size_t ws_size, hipStream_t stream) {
  Params p{};
  for (int i = 0; i < 24; ++i) p.in[i] = (const float*)d_in[i];
  p.out = (float*)d_out;
  p.ws = (unsigned char*)d_ws;
#if MULTI_LAUNCH
  for (int ph = 0; ph < N_PHASES; ++ph) {
    p.phase_lo = ph; p.phase_hi = ph + 1;
    hipLaunchKernelGGL(mega<false>, dim3(512), dim3(NT), LDS_BYTES + 16, stream, p);
  }
#else
  static int grid_blocks = 0;
  if (!grid_blocks) {
    int dev = 0, cus = 0, per_cu = 0;
    hipGetDevice(&dev);
    hipDeviceGetAttribute(&cus, hipDeviceAttributeMultiprocessorCount, dev);
    (void)hipFuncSetAttribute((const void*)mega<true>, hipFuncAttributeMaxDynamicSharedMemorySize, LDS_BYTES + 16);
    hipOccupancyMaxActiveBlocksPerMultiprocessor(&per_cu, mega<true>, NT, LDS_BYTES + 16);
    if (per_cu > 2) per_cu = 2;
    if (per_cu < 1) per_cu = 1;
    grid_blocks = cus * per_cu;
  }
  p.phase_lo = 0; p.phase_hi = N_PHASES;
  void* args[] = {&p};
  hipError_t e = hipLaunchCooperativeKernel((void*)mega<true>, dim3(grid_blocks), dim3(NT), args, LDS_BYTES + 16, stream);
  if (e != hipSuccess) fprintf(stderr, "cooperative launch failed: %s (grid %d)\n", hipGetErrorString(e), grid_blocks);
#endif
}
#endif
```

```cpp
#include <hip/hip_runtime.h>
#include <hip/hip_cooperative_groups.h>
#include <cstdio>
#include <cstdint>
namespace cg = cooperative_groups;

typedef unsigned short u16;
typedef unsigned int u32;
using bf16x8 = __attribute__((ext_vector_type(8))) short;
using f32x4 = __attribute__((ext_vector_type(4))) float;

#ifndef REPEAT_MASK
#define REPEAT_MASK 0
#endif
#ifndef MULTI_LAUNCH
#define MULTI_LAUNCH 0
#endif

constexpr int NT = 512;
constexpr int Bsz = 4, T = 4096, D = 1024, M = Bsz * T;
constexpr int INW = 3216, INP = 3328;
constexpr int DFF = 4096;
constexpr int SBQ = 0, SBK = 384, SBV = 768;
constexpr int RW0 = 1152;
constexpr int GL0 = 2432;
constexpr float EPS = 1e-6f;
constexpr float LOG2E = 1.4426950408889634f;

constexpr size_t WS_CTRL = 0;
constexpr size_t WS_WIN = 1u << 20;
constexpr size_t WS_WOUT = WS_WIN + (size_t)INP * D * 2;
constexpr size_t WS_WF1 = WS_WOUT + (size_t)D * D * 2;
constexpr size_t WS_WF2 = WS_WF1 + (size_t)DFF * D * 2;
constexpr size_t WS_ABUF = WS_WF2 + (size_t)DFF * D * 2;
constexpr size_t WS_BIG = WS_ABUF + (size_t)M * D * 2;
constexpr size_t WS_PROJ = WS_BIG;
constexpr size_t WS_RWP = WS_PROJ + (size_t)M * INW * 2;
constexpr size_t WS_VY = WS_RWP + (size_t)M * 384 * 12;
constexpr size_t WS_GLAS = WS_VY + (size_t)M * 384 * 2;
constexpr size_t WS_GLAD = WS_GLAS + (size_t)1024 * 2048 * 4;
constexpr size_t WS_MIX_END = WS_GLAD + (size_t)1024 * 32 * 4;
constexpr size_t WS_CBUF = WS_BIG;
constexpr size_t WS_FFH = WS_CBUF + (size_t)M * D * 4;
constexpr size_t WS_FFN_END = WS_FFH + (size_t)M * DFF * 2;
static_assert(WS_MIX_END <= (256u << 20) && WS_FFN_END <= (256u << 20), "workspace");

struct Params {
  const float* in[24];
  float* out;
  unsigned char* ws;
  int phase_lo, phase_hi;
};

__device__ __forceinline__ u16 f2bf(float f) {
  u32 u = __float_as_uint(f);
  u += 0x7fffu + ((u >> 16) & 1u);
  return (u16)(u >> 16);
}
__device__ __forceinline__ float bf2f(u16 h) { return __uint_as_float(((u32)h) << 16); }
__device__ __forceinline__ u32 pack2(float lo, float hi) { return (u32)f2bf(lo) | ((u32)f2bf(hi) << 16); }
__device__ __forceinline__ float wsum_shfl(float v) {
#pragma unroll
  for (int o = 32; o > 0; o >>= 1) v += __shfl_xor(v, o, 64);
  return v;
}
template <int CTRL>
__device__ __forceinline__ float dppx(float x) {
  return __builtin_bit_cast(float, __builtin_amdgcn_mov_dpp(__builtin_bit_cast(int, x), CTRL, 0xf, 0xf, true));
}
__device__ __forceinline__ float wsum_dpp63(float v) {
  v += dppx<0xB1>(v);
  v += dppx<0x4E>(v);
  v += dppx<0x141>(v);
  v += dppx<0x128>(v);
  v += dppx<0x142>(v);
  v += dppx<0x143>(v);
  return v;
}
__device__ __forceinline__ float rdlane63(float v);
__device__ __forceinline__ float wsum_u(float v) { return rdlane63(wsum_dpp63(v)); }
__device__ __forceinline__ float rdlane63(float v) {
  return __builtin_bit_cast(float, __builtin_amdgcn_readlane(__builtin_bit_cast(int, v), 63));
}
__device__ __forceinline__ void lds_barrier() { asm volatile("s_waitcnt lgkmcnt(0)\n\ts_barrier" ::: "memory"); }
__device__ __forceinline__ void glds16(const void* g, unsigned lds_base) {
  unsigned sv;
  asm volatile("s_mov_b32 %0, m0\n\ts_mov_b32 m0, %2\n\ts_nop 0\n\tglobal_load_lds_dwordx4 %1, off\n\ts_mov_b32 m0, %0"
               : "=&s"(sv) : "v"(g), "s"(lds_base) : "memory");
}
__device__ __forceinline__ int opaque_tid() { int t = threadIdx.x; asm volatile("" : "+v"(t)); return t; }
__device__ __forceinline__ float softplus_f(float x) {
  return fmaxf(x, 0.f) + __logf(1.f + __expf(-fabsf(x)));
}

__device__ void prep_weight(const float* __restrict__ W, const float* __restrict__ gain, u16* __restrict__ Wt,
                            int K, int N, int Npad, float* lds, int bid, int G) {
  const int tid = opaque_tid();
  const int tk_n = K / 64, tn_n = Npad / 64;
  for (int tile = bid; tile < tk_n * tn_n; tile += G) {
    const int tk = tile % tk_n, tn = tile / tk_n;
    const int k0 = tk * 64, n0 = tn * 64;
    const int j = tid & 63, i0 = tid >> 6;
#pragma unroll
    for (int r = 0; r < 8; ++r) {
      const int i = i0 + 8 * r;
      const int n = n0 + j;
      float v = 0.f;
      if (n < N) { v = W[(size_t)(k0 + i) * N + n]; if (gain) v *= gain[k0 + i]; }
      lds[i * 65 + j] = v;
    }
    __syncthreads();
#pragma unroll
    for (int r = 0; r < 4; ++r) {
      const int jn = (tid >> 5) + 16 * r;
      const int ik = (tid & 31) * 2;
      *(u32*)(Wt + (size_t)(n0 + jn) * K + k0 + ik) = pack2(lds[ik * 65 + jn], lds[(ik + 1) * 65 + jn]);
    }
    __syncthreads();
  }
}

__device__ void prep_weights_layer(const Params& p, int l, float* lds, int G) {
  unsigned char* ws = p.ws;
  prep_weight(p.in[2] + (size_t)l * D * INW, p.in[1] + l * D, (u16*)(ws + WS_WIN), D, INW, INP, lds, blockIdx.x, G);
  prep_weight(p.in[18] + (size_t)l * D * D, nullptr, (u16*)(ws + WS_WOUT), D, D, D, lds, blockIdx.x, G);
  prep_weight(p.in[21] + (size_t)l * D * DFF, p.in[20] + l * D, (u16*)(ws + WS_WF1), D, DFF, DFF, lds, blockIdx.x, G);
  prep_weight(p.in[22] + (size_t)l * DFF * D, nullptr, (u16*)(ws + WS_WF2), DFF, D, D, lds, blockIdx.x, G);
}

__device__ void row_phase(const float* __restrict__ xold, const u16* __restrict__ y, const float* __restrict__ gain,
                          float* __restrict__ xnew, u16* __restrict__ hn, int G) {
  const int tid = opaque_tid(); const int lane = tid & 63, wave = tid >> 6;
  for (int row = blockIdx.x * 8 + wave; row < M; row += G * 8) {
    float4 xv[4];
#pragma unroll
    for (int j = 0; j < 4; ++j) xv[j] = *(const float4*)(xold + (size_t)row * D + j * 256 + lane * 4);
    if (y) {
      float4 yv[4];
      float ss = 0.f;
#pragma unroll
      for (int j = 0; j < 4; ++j) {
        const uint2 yr = *(const uint2*)(y + (size_t)row * D + j * 256 + lane * 4);
        yv[j].x = __uint_as_float(yr.x << 16); yv[j].y = __uint_as_float(yr.x & 0xffff0000u);
        yv[j].z = __uint_as_float(yr.y << 16); yv[j].w = __uint_as_float(yr.y & 0xffff0000u);
        ss += yv[j].x * yv[j].x + yv[j].y * yv[j].y + yv[j].z * yv[j].z + yv[j].w * yv[j].w;
      }
      ss = wsum_u(ss);
      const float rs = rsqrtf(ss * (1.f / D) + EPS);
#pragma unroll
      for (int j = 0; j < 4; ++j) {
        const float4 g = *(const float4*)(gain + j * 256 + lane * 4);
        xv[j].x += yv[j].x * rs * g.x; xv[j].y += yv[j].y * rs * g.y;
        xv[j].z += yv[j].z * rs * g.z; xv[j].w += yv[j].w * rs * g.w;
      }
    }
    if (xnew) {
#pragma unroll
      for (int j = 0; j < 4; ++j) *(float4*)(xnew + (size_t)row * D + j * 256 + lane * 4) = xv[j];
    }
    if (hn) {
      float ss = 0.f;
#pragma unroll
      for (int j = 0; j < 4; ++j) ss += xv[j].x * xv[j].x + xv[j].y * xv[j].y + xv[j].z * xv[j].z + xv[j].w * xv[j].w;
      ss = wsum_u(ss);
      const float rs = rsqrtf(ss * (1.f / D) + EPS);
#pragma unroll
      for (int j = 0; j < 4; ++j) {
        uint2 o;
        o.x = pack2(xv[j].x * rs, xv[j].y * rs);
        o.y = pack2(xv[j].z * rs, xv[j].w * rs);
        *(uint2*)(hn + (size_t)row * D + j * 256 + lane * 4) = o;
      }
    }
  }
}

constexpr int EPI_BF16 = 0, EPI_RELU2 = 1, EPI_F32 = 2;
constexpr int GBM = 256, GBN = 128, GBK = 64, GLD = 64;
template <int EPI>
__device__ void gemm_phase(const u16* __restrict__ A, const u16* __restrict__ Bt, void* __restrict__ Cv,
                           int N, int K, int ldc, unsigned char* ldsraw, int G) {
  u16* As = (u16*)ldsraw;
  u16* Bs = As + 2 * GBM * GLD;
  const int tid = opaque_tid(), lane = tid & 63, wave = tid >> 6;
  const int wm = wave >> 1, wn = wave & 1;
  const int l15 = lane & 15, g4 = lane >> 4;
  const int ntn = (N + GBN - 1) / GBN, ntm = M / GBM;
  const int nk = K / GBK;
  const bool swz = (G == 256) && (ntn != 32);
  const int t_begin = swz ? (int)(blockIdx.x >> 3) : (int)blockIdx.x;
  const int t_step = swz ? 32 : G;
  const int t_end = swz ? (ntm / 8) * ntn : ntm * ntn;
  for (int tile = t_begin; tile < t_end; tile += t_step) {
    int tn = tile % ntn, tm = tile / ntn;
    if (swz) tm = (blockIdx.x & 7) + 8 * tm;
    const int m0 = tm * GBM, n0 = tn * GBN;
    f32x4 acc[4][4];
#pragma unroll
    for (int i = 0; i < 4; ++i)
#pragma unroll
      for (int j = 0; j < 4; ++j) acc[i][j] = (f32x4){0.f, 0.f, 0.f, 0.f};
    const int ar0 = tid >> 3, acc4 = tid & 7;
    const int ssw = (acc4 ^ ((ar0 >> 1) & 7)) * 8;
    const int fx = (l15 >> 1) & 7;
    const u16* Ag0 = A + (size_t)(m0 + ar0) * K + ssw;
    const u16* Bg = Bt + (size_t)(n0 + ar0) * K + ssw;
    const size_t r64 = (size_t)64 * K;
    constexpr int STG = (GBM + GBN) * GLD;
    const unsigned lw0 = (unsigned)__builtin_amdgcn_readfirstlane((int)(unsigned)(uintptr_t)(As + wave * 8 * GLD));
#define GLDS(st_, kt_) { const int kk_ = ((kt_) < nk ? (kt_) : nk - 1) * GBK; const unsigned d_ = lw0 + (unsigned)(st_) * (STG * 2); \
      glds16(Ag0 + kk_, d_); glds16(Ag0 + r64 + kk_, d_ + 64 * GLD * 2); glds16(Ag0 + 2 * r64 + kk_, d_ + 128 * GLD * 2); glds16(Ag0 + 3 * r64 + kk_, d_ + 192 * GLD * 2); \
      glds16(Bg + kk_, d_ + GBM * GLD * 2); glds16(Bg + r64 + kk_, d_ + (GBM + 64) * GLD * 2); }
    GLDS(0, 0);
    GLDS(1, 1);
    int st = 0;
    for (int kt = 0; kt < nk; ++kt) {
      asm volatile("s_waitcnt vmcnt(6)" ::: "memory");
      lds_barrier();
      const int st2 = (st >= 1) ? st - 1 : 2;
      GLDS(st2, kt + 2);
      const u16* Asx = As + st * STG;
      const u16* Bsx = Asx + GBM * GLD;
#pragma unroll
      for (int ks = 0; ks < 2; ++ks) {
        const int fsw = ((ks * 4 + g4) ^ fx) * 8;
        bf16x8 bfr[4];
#pragma unroll
        for (int jx = 0; jx < 4; ++jx) bfr[jx] = *(const bf16x8*)(Bsx + (wn * 64 + jx * 16 + l15) * GLD + fsw);
#pragma unroll
        for (int ix = 0; ix < 4; ++ix) {
          const bf16x8 af = *(const bf16x8*)(Asx + (wm * 64 + ix * 16 + l15) * GLD + fsw);
#pragma unroll
          for (int jx = 0; jx < 4; ++jx)
            acc[ix][jx] = __builtin_amdgcn_mfma_f32_16x16x32_bf16(af, bfr[jx], acc[ix][jx], 0, 0, 0);
        }
      }
      st = (st == 2) ? 0 : st + 1;
    }
    asm volatile("s_waitcnt vmcnt(0)" ::: "memory");
    lds_barrier();
#undef GLDS
#pragma unroll
    for (int i = 0; i < 4; ++i) {
#pragma unroll
      for (int r = 0; r < 4; ++r) {
        const int m = m0 + wm * 64 + i * 16 + g4 * 4 + r;
        const int nb = n0 + wn * 64 + l15;
        if (EPI == EPI_F32) {
          float* cp = (float*)Cv + (size_t)m * ldc + nb;
#pragma unroll
          for (int j = 0; j < 4; ++j) if (nb + j * 16 < N) cp[j * 16] = acc[i][j][r];
        } else {
          u16* cp = (u16*)Cv + (size_t)m * ldc + nb;
#pragma unroll
          for (int j = 0; j < 4; ++j) {
            float v = acc[i][j][r];
            if (EPI == EPI_RELU2) { v = fmaxf(v, 0.f); v = v * v; }
            if (nb + j * 16 < N) cp[j * 16] = f2bf(v);
          }
        }
      }
      __builtin_amdgcn_sched_barrier(0);
    }
  }
}

__device__ void rwprep_items(const Params& p, int l, unsigned char* ldsraw, int it_begin, int it_end, int it_step) {
  float* codes = (float*)ldsraw;
  const u16* proj = (const u16*)(p.ws + WS_PROJ);
  u32* rwp = (u32*)(p.ws + WS_RWP);
  u16* vy = (u16*)(p.ws + WS_VY);
  const float* mu = p.in[4] + l * 1280;
  const float* w0 = p.in[5] + l * 384;
  const float* w_up = p.in[6] + l * 32 * 384;
  const float* a0 = p.in[7] + l * 384;
  const float* a_up = p.in[8] + l * 32 * 384;
  const float* k_k = p.in[10] + l * 384;
  const float* k_a = p.in[11] + l * 384;
  const float* r_k = p.in[12] + l * 384;
  float* bon = (float*)(p.ws + WS_CTRL + 65536);
  const int tid = opaque_tid();
  for (int it = it_begin; it < it_end; it += it_step) {
    const int tok0 = it * 4;
    if (tid < 256) {
      const int tt = tid >> 6, j = tid & 63;
      const int tok = tok0 + tt;
      const int col = 1152 + j;
      const float pc = bf2f(proj[(size_t)tok * INW + RW0 + col]);
      const float pp = (tok % T == 0) ? 0.f : bf2f(proj[(size_t)(tok - 1) * INW + RW0 + col]);
      float s = pc + (pp - pc) * mu[col];
      if (j < 32) { const float e2 = __expf(2.f * s); s = 1.f - 2.f / (e2 + 1.f); }
      codes[tt * 64 + j] = s;
    }
    __syncthreads();
    if (tid < 384) {
      const int c = tid;
      float aw[4], aa[4];
      float pr_[5], pk_[5], pv_[5];
#pragma unroll
      for (int tt = 0; tt < 4; ++tt) { aw[tt] = 0.f; aa[tt] = 0.f; }
#pragma unroll
      for (int tt = 0; tt < 5; ++tt) {
        const int tok = tok0 + tt - 1;
        const bool ok = (tt > 0) || (tok0 % T != 0);
        const u16* pq = proj + (size_t)(ok ? tok : tok0) * INW + RW0;
        pr_[tt] = ok ? bf2f(pq[c]) : 0.f; pk_[tt] = ok ? bf2f(pq[384 + c]) : 0.f; pv_[tt] = ok ? bf2f(pq[768 + c]) : 0.f;
      }
#pragma unroll 4
      for (int j = 0; j < 32; ++j) {
        const float wu = w_up[j * 384 + c], au = a_up[j * 384 + c];
#pragma unroll
        for (int tt = 0; tt < 4; ++tt) {
          aw[tt] += codes[tt * 64 + j] * wu;
          aa[tt] += codes[tt * 64 + 32 + j] * au;
        }
      }
      const float mur = mu[c], muk = mu[384 + c], muv = mu[768 + c];
      const float w0c = w0[c], a0c = a0[c], kkc = k_k[c], kac = k_a[c], rkc = r_k[c];
#pragma unroll
      for (int tt = 0; tt < 4; ++tt) {
        const int tok = tok0 + tt;
        float r = pr_[tt + 1], k = pk_[tt + 1], v = pv_[tt + 1];
        const float r1 = pr_[tt], k1 = pk_[tt], v1 = pv_[tt];
        r += (r1 - r) * mur; k += (k1 - k) * muk; v += (v1 - v) * muv;
        const float xw = w0c + aw[tt];
        const float lw = -softplus_f(-xw) - 0.5f;
        const float dec = __expf(-__expf(lw));
        const float xa = a0c + aa[tt];
        const float asig = 1.f / (1.f + __expf(-xa));
        const float kkr = k * kkc;
        const float ssum = wsum_u(kkr * kkr);
        const float kk = kkr * rsqrtf(fmaxf(ssum, 1e-12f));
        const float kmod = k * (1.f + (asig - 1.f) * kac);
        const size_t o = ((size_t)tok * 384 + c) * 3;
        rwp[o] = __float_as_uint(dec);
        rwp[o + 1] = pack2(kk, kk * asig);
        rwp[o + 2] = pack2(kmod, r);
        const float bsum = wsum_u(r * kmod * rkc);
        if ((tid & 63) == 0) bon[(size_t)tok * 6 + (tid >> 6)] = bsum;
        vy[(size_t)tok * 384 + c] = f2bf(v);
      }
    }
    __syncthreads();
  }
}

constexpr int TC = 8;
constexpr int PRF = 592;
constexpr int CHF = 4 * PRF + TC * 16;
__device__ __forceinline__ float rowsum16(float v) {
  v += dppx<0xB1>(v);
  v += dppx<0x4E>(v);
  v += dppx<0x141>(v);
  v += dppx<0x128>(v);
  return v;
}
__device__ __forceinline__ float dot4(float a0, float a1, float a2, float a3, const float4& b) {
  return fmaf(a1, b.y, a0 * b.x) + fmaf(a3, b.w, a2 * b.z);
}
__device__ void rwscan_item(const Params& p, int l, int item, unsigned char* ldsraw) {
  float* lp = (float*)ldsraw;
  const u32* rwp = (const u32*)(p.ws + WS_RWP);
  const int tid = opaque_tid(), lane = tid & 63, wave = tid >> 6;
  const int bh = item >> 2, q4 = item & 3;
  const int b = bh / 6, h = bh % 6;
  const size_t tokb = (size_t)b * T;
  const int cg = lane & 15, rsel = lane >> 4;
  const int nch = T / TC;
  if (wave >= 4) {
    const int j = wave - 4;
    const u32* src = rwp + ((tokb + 2 * j) * 384 + h * 64 + lane) * 3;
    const u16* srcv = (const u16*)(p.ws + WS_VY) + (tokb + 2 * j + ((lane >> 4) & 1)) * 384 + h * 64 + q4 * 16 + (lane & 15);
    u32 S0[6], S1[6], S2[6], S3[6]; u16 V0, V1, V2, V3;
    int ready_chunk = -1;
    const u32* prep_done = (const u32*)(p.ws + WS_CTRL) + 512 + l * 256;
    u32* scan_done = (u32*)(p.ws + WS_CTRL) + 1024 + l * 256;
#define LD_SET(S, V, chunk) { \
      const int cc_ = (chunk) < nch ? (chunk) : nch - 1; \
      if ((cc_ & 7) == 0 && cc_ > ready_chunk) { \
          \
        const u32* rc_ = prep_done + b * 64 + (cc_ >> 3); \
        while (__hip_atomic_load(rc_, __ATOMIC_RELAXED, __HIP_MEMORY_SCOPE_AGENT) < 4u) __builtin_amdgcn_s_sleep(4); \
        __builtin_amdgcn_fence(__ATOMIC_ACQUIRE, "agent"); \
        asm volatile("s_waitcnt vmcnt(0)" ::: "memory"); \
        ready_chunk = cc_; \
      } \
      const size_t go = (size_t)cc_ * TC * 384 * 3; \
      S[0] = src[go]; S[1] = src[go + 1]; S[2] = src[go + 2]; S[3] = src[go + 1152]; S[4] = src[go + 1153]; S[5] = src[go + 1154]; \
      V = srcv[(size_t)cc_ * TC * 384]; }
#define PROC_SET(S, V, buf) { \
      const float w1 = __uint_as_float(S[0]), kk1 = __uint_as_float(S[1] << 16), b1 = __uint_as_float(S[1] & 0xffff0000u); \
      const float km1 = __uint_as_float(S[2] << 16), r1 = __uint_as_float(S[2] & 0xffff0000u); \
      const float w2 = __uint_as_float(S[3]), kk2 = __uint_as_float(S[4] << 16), b2 = __uint_as_float(S[4] & 0xffff0000u); \
      const float km2 = __uint_as_float(S[5] << 16), r2 = __uint_as_float(S[5] & 0xffff0000u); \
      const float U0 = w1 * w2, U1 = b1 * w2, U2 = km1 * w2; \
      float* pb = lp + (buf) * CHF + j * PRF; \
      pb[lane] = kk1; pb[64 + lane] = w1 * kk2; pb[128 + lane] = w1 * r1; pb[192 + lane] = U0 * r2; \
      pb[256 + lane] = U0; pb[320 + lane] = U1; pb[384 + lane] = U2; pb[448 + lane] = b2; pb[512 + lane] = km2; \
      const float c1 = wsum_dpp63(b1 * kk2), c2 = wsum_dpp63(km1 * kk2), c3 = wsum_dpp63(b1 * r1), c4 = wsum_dpp63(km1 * r1); \
      const float c5 = wsum_dpp63(U1 * r2), c6 = wsum_dpp63(U2 * r2), c7 = wsum_dpp63(b2 * r2), c8 = wsum_dpp63(km2 * r2); \
      if (lane == 63) { *(float4*)(pb + 576) = make_float4(c1, c2, c3, c4); *(float4*)(pb + 580) = make_float4(c5, c6, c7, c8); } \
      if (lane < 32) lp[(buf) * CHF + 4 * PRF + (2 * j + (lane >> 4)) * 16 + (lane & 15)] = bf2f(V); }
    LD_SET(S0, V0, 0);
    PROC_SET(S0, V0, 0);
    LD_SET(S1, V1, 1);
    LD_SET(S2, V2, 2);
    LD_SET(S3, V3, 3);
    LD_SET(S0, V0, 4);
    lds_barrier();
    for (int ch = 0; ch < nch; ch += 4) {
      PROC_SET(S1, V1, 1); LD_SET(S1, V1, ch + 5); lds_barrier();
      PROC_SET(S2, V2, 0); LD_SET(S2, V2, ch + 6); lds_barrier();
      PROC_SET(S3, V3, 1); LD_SET(S3, V3, ch + 7); lds_barrier();
      PROC_SET(S0, V0, 0); LD_SET(S0, V0, ch + 8); lds_barrier();
      if (((ch + 4) & 7) == 0 && ch + 4 >= 16 && wave == 4 && lane == 0) {
        __hip_atomic_fetch_add(scan_done + b * 64 + ((ch + 4) >> 3) - 2, 1u, __ATOMIC_RELAXED, __HIP_MEMORY_SCOPE_AGENT);
      }
    }
#undef LD_SET
#undef PROC_SET
  } else {
    typedef float f32x2 __attribute__((ext_vector_type(2)));
    f32x2 sa = {0.f, 0.f}, sb = {0.f, 0.f};
    const int row = q4 * 16 + wave * 4 + rsel;
    const bool bit0 = (lane & 1) != 0, bit1 = (lane & 2) != 0, isy1 = (cg & 3) == 2;
    u16* yl = (u16*)(p.ws + WS_ABUF) + (tokb + 2 * (cg >> 2) + (cg & 1)) * D + 384 + h * 64 + row;
    lds_barrier();
    for (int ch = 0; ch < nch; ++ch) {
      const float* cb = lp + (ch & 1) * CHF;
      float yv[4];
#pragma unroll
      for (int j = 0; j < 4; ++j) {
        const f32x2* pb = (const f32x2*)(cb + j * PRF + cg * 4);
#define LDV(k, lo, hi) const f32x2 lo = pb[(k) * 32], hi = pb[(k) * 32 + 1];
        LDV(0, A1a, A1b) LDV(1, A2a, A2b) LDV(2, A3a, A3b) LDV(3, A4a, A4b)
        LDV(4, U0a, U0b) LDV(5, U1a, U1b) LDV(6, U2a, U2b) LDV(7, U3a, U3b) LDV(8, U4a, U4b)
#undef LDV
        const float4 ca = *(const float4*)(cb + j * PRF + 576), cc = *(const float4*)(cb + j * PRF + 580);
        const float v1 = cb[4 * PRF + (2 * j) * 16 + wave * 4 + rsel];
        const float v2 = cb[4 * PRF + (2 * j + 1) * 16 + wave * 4 + rsel];
        f32x2 t1 = sa * A1a + sb * A1b, t2 = sa * A2a + sb * A2b, t3 = sa * A3a + sb * A3b, t4 = sa * A4a + sb * A4b;
        const float p1 = t1.x + t1.y, p2 = t2.x + t2.y, p3 = t3.x + t3.y, p4 = t4.x + t4.y;
        const float u12 = (bit0 ? p2 : p1) + dppx<0xB1>(bit0 ? p1 : p2);
        const float u34 = (bit0 ? p4 : p3) + dppx<0xB1>(bit0 ? p3 : p4);
        float wq = (bit1 ? u34 : u12) + dppx<0x4E>(bit1 ? u12 : u34);
        wq += dppx<0x124>(wq);
        wq += dppx<0x128>(wq);
        const float d1 = -dppx<0x00>(wq);
        const float d2 = -(dppx<0x55>(wq) + d1 * ca.x + v1 * ca.y);
        const float e1 = isy1 ? ca.z : cc.x, e2 = isy1 ? ca.w : cc.y, e3 = isy1 ? 0.f : cc.z, e4 = isy1 ? 0.f : cc.w;
        yv[j] = wq + d1 * e1 + v1 * e2 + d2 * e3 + v2 * e4;
        sa = sa * U0a + d1 * U1a + v1 * U2a + d2 * U3a + v2 * U4a;
        sb = sb * U0b + d1 * U1b + v1 * U2b + d2 * U3b + v2 * U4b;
      }
      {
        float ym = 0.f;
#pragma unroll
        for (int jj = 0; jj < 4; ++jj) ym = ((cg >> 2) == jj) ? yv[jj] : ym;
        if ((cg & 2) != 0) __hip_atomic_store(yl, f2bf(ym), __ATOMIC_RELAXED, __HIP_MEMORY_SCOPE_AGENT);
        yl += (size_t)TC * D;
      }
      if ((ch & 7) == 7) asm volatile("s_waitcnt vmcnt(8)" ::: "memory");
      lds_barrier();
    }
  }
  __syncthreads();
  if (tid == 256) __hip_atomic_fetch_add((u32*)(p.ws + WS_CTRL) + 1024 + l * 256 + b * 64 + 63, 1u, __ATOMIC_RELAXED, __HIP_MEMORY_SCOPE_AGENT);
}

constexpr int KLD = 72;
__device__ void sbattn_item(const Params& p, int l, int item, unsigned char* ldsraw) {
  u16* Ks = (u16*)ldsraw;
  u16* Vt = Ks + 64 * KLD;
  const u16* proj = (const u16*)(p.ws + WS_PROJ);
  u16* mix = (u16*)(p.ws + WS_ABUF);
  const float* ng = p.in[3] + l * 384;
  const int tid = opaque_tid(), lane = tid & 63, wave = tid >> 6;
  const int l15 = lane & 15, g4 = lane >> 4;
  const int bh = item % 24, qb = 31 - item / 24;
  const int b = bh / 6, h = bh % 6;
  const size_t tokb = (size_t)b * T;
  const int Q0 = qb * 128, q0 = Q0 + wave * 16;
  const int qi = q0 + l15;
  bf16x8 bq[2];
#pragma unroll
  for (int ks = 0; ks < 2; ++ks)
    bq[ks] = *(const bf16x8*)(proj + (tokb + qi) * INW + SBQ + h * 64 + ks * 32 + g4 * 8);
  bf16x8 P0, P1, ONES;
#pragma unroll
  for (int i = 0; i < 8; ++i) {
    const int jj = (i < 4) ? (4 * g4 + i) : (16 + 4 * g4 + (i - 4));
    P0[i] = (jj > l15) ? (short)0x3F80 : (short)0;
    P1[i] = (jj > 16 + l15) ? (short)0x3F80 : (short)0;
    ONES[i] = (short)0x3F80;
  }
  f32x4 ot[4];
#pragma unroll
  for (int i = 0; i < 4; ++i) ot[i] = (f32x4){0.f, 0.f, 0.f, 0.f};
  float carry = 0.f;
  const float SC = 0.125f * LOG2E;
  const int kb_hi = 2 * qb + 1;
  const int kb_diag = q0 >> 6;
  for (int kb = kb_hi; kb >= 0; --kb) {
    if (__syncthreads_and(carry < -151.f)) break;
    {
      const int key = tid >> 3, ch = tid & 7;
      const u16* src = proj + (tokb + kb * 64 + key) * INW + h * 64 + ch * 8;
      const uint4 kv = *(const uint4*)(src + SBK);
      const uint4 vv = *(const uint4*)(src + SBV);
      *(uint4*)(Ks + key * KLD + ch * 8) = kv;
      const u32 w[4] = {vv.x, vv.y, vv.z, vv.w};
#pragma unroll
      for (int i = 0; i < 4; ++i) {
        Vt[(ch * 8 + 2 * i) * KLD + key] = (u16)(w[i] & 0xffffu);
        Vt[(ch * 8 + 2 * i + 1) * KLD + key] = (u16)(w[i] >> 16);
      }
    }
    __syncthreads();
    if (kb > kb_diag) continue;
    f32x4 st[4];
#pragma unroll
    for (int f = 0; f < 4; ++f) {
      st[f] = (f32x4){0.f, 0.f, 0.f, 0.f};
#pragma unroll
      for (int ks = 0; ks < 2; ++ks) {
        const bf16x8 ak = *(const bf16x8*)(Ks + (f * 16 + l15) * KLD + ks * 32 + g4 * 8);
        st[f] = __builtin_amdgcn_mfma_f32_16x16x32_bf16(ak, bq[ks], st[f], 0, 0, 0);
      }
    }
    float e0[4][4];
    bf16x8 lb[2];
    const bool diag = (kb == kb_diag);
#pragma unroll
    for (int f = 0; f < 4; ++f)
#pragma unroll
      for (int j = 0; j < 4; ++j) {
        const float t = st[f][j] * SC;
        float lv = -(fmaxf(t, 0.f) + __builtin_amdgcn_logf(1.f + __builtin_amdgcn_exp2f(-fabsf(t))));
        e0[f][j] = t + lv;
        if (diag) { const int key = kb * 64 + 16 * f + 4 * g4 + j; if (key >= qi) lv = 0.f; }
        lb[f >> 1][(f & 1) * 4 + j] = (short)f2bf(lv);
      }
    const f32x4 cv = (f32x4){carry, carry, carry, carry};
    f32x4 tot = __builtin_amdgcn_mfma_f32_16x16x32_bf16(ONES, lb[0], cv, 0, 0, 0);
    tot = __builtin_amdgcn_mfma_f32_16x16x32_bf16(ONES, lb[1], tot, 0, 0, 0);
    bf16x8 wb[2];
#pragma unroll
    for (int f = 0; f < 4; ++f) {
      f32x4 bt;
      if (f == 0) { bt = __builtin_amdgcn_mfma_f32_16x16x32_bf16(P0, lb[0], cv, 0, 0, 0); bt = __builtin_amdgcn_mfma_f32_16x16x32_bf16(ONES, lb[1], bt, 0, 0, 0); }
      else if (f == 1) { bt = __builtin_amdgcn_mfma_f32_16x16x32_bf16(P1, lb[0], cv, 0, 0, 0); bt = __builtin_amdgcn_mfma_f32_16x16x32_bf16(ONES, lb[1], bt, 0, 0, 0); }
      else if (f == 2) bt = __builtin_amdgcn_mfma_f32_16x16x32_bf16(P0, lb[1], cv, 0, 0, 0);
      else bt = __builtin_amdgcn_mfma_f32_16x16x32_bf16(P1, lb[1], cv, 0, 0, 0);
#pragma unroll
      for (int j = 0; j < 4; ++j) {
        float w = __builtin_amdgcn_exp2f(e0[f][j] + bt[j]);
        if (diag) { const int key = kb * 64 + 16 * f + 4 * g4 + j; if (key >= qi) w = 0.f; }
        wb[f >> 1][(f & 1) * 4 + j] = (short)f2bf(w);
      }
    }
#pragma unroll
    for (int df = 0; df < 4; ++df)
#pragma unroll
      for (int k2 = 0; k2 < 2; ++k2) {
        const u16* vp = Vt + (df * 16 + l15) * KLD + k2 * 32 + 4 * g4;
        const uint2 lo = *(const uint2*)(vp);
        const uint2 hi = *(const uint2*)(vp + 16);
        bf16x8 av;
        av[0] = (short)(lo.x & 0xffff); av[1] = (short)(lo.x >> 16); av[2] = (short)(lo.y & 0xffff); av[3] = (short)(lo.y >> 16);
        av[4] = (short)(hi.x & 0xffff); av[5] = (short)(hi.x >> 16); av[6] = (short)(hi.y & 0xffff); av[7] = (short)(hi.y >> 16);
        ot[df] = __builtin_amdgcn_mfma_f32_16x16x32_bf16(av, wb[k2], ot[df], 0, 0, 0);
      }
    carry = tot[0];
  }
  float ss = 0.f;
#pragma unroll
  for (int df = 0; df < 4; ++df)
#pragma unroll
    for (int j = 0; j < 4; ++j) ss += ot[df][j] * ot[df][j];
  ss += __shfl_xor(ss, 16, 64);
  ss += __shfl_xor(ss, 32, 64);
  const float rs = rsqrtf(ss * (1.f / 64.f) + EPS);
#pragma unroll
  for (int df = 0; df < 4; ++df) {
    const int d = 16 * df + 4 * g4;
    const float4 gg = *(const float4*)(ng + h * 64 + d);
    uint2 o;
    o.x = pack2(ot[df][0] * rs * gg.x, ot[df][1] * rs * gg.y);
    o.y = pack2(ot[df][2] * rs * gg.z, ot[df][3] * rs * gg.w);
    *(uint2*)(mix + (tokb + qi) * D + h * 64 + d) = o;
  }
  __syncthreads();
}

__device__ void gla_load(const Params& p, int l, int b, int h, int c, float* qs, float* ks, float* vs, float* bc, float* gds) {
  const u16* proj = (const u16*)(p.ws + WS_PROJ);
  const float* gate_up = p.in[15] + l * 16 * 128;
  const float* gate_b = p.in[16] + l * 128;
  const int tid = opaque_tid();
  const size_t tok0 = (size_t)b * T + c * 64;
  const float qsc = 0.17677669529663687f;
  for (int e = tid; e < 64 * 32; e += NT) {
    const int t = e >> 5, k = e & 31;
    const u16* pr = proj + (tok0 + t) * INW + GL0;
    qs[e] = bf2f(pr[h * 32 + k]) * qsc;
    ks[e] = bf2f(pr[128 + h * 32 + k]);
  }
  for (int e = tid; e < 64 * 64; e += NT) {
    const int t = e >> 6, v = e & 63;
    vs[e] = bf2f(proj[(tok0 + t) * INW + GL0 + 256 + h * 64 + v]);
  }
  for (int e = tid; e < 64 * 16; e += NT) {
    const int t = e >> 4, j = e & 15;
    gds[e] = bf2f(proj[(tok0 + t) * INW + GL0 + 512 + j]);
  }
  __syncthreads();
  for (int e = tid; e < 64 * 32; e += NT) {
    const int t = e >> 5, k = e & 31;
    float x = gate_b[h * 32 + k];
#pragma unroll
    for (int j = 0; j < 16; ++j) x += gds[t * 16 + j] * gate_up[j * 128 + h * 32 + k];
    bc[e] = -softplus_f(-x) * (1.f / 16.f);
  }
  __syncthreads();
  {
    const int k = tid & 31, seg = (tid >> 5) & 7;
    float v[8];
    if (tid < 256) {
      float a = 0.f;
#pragma unroll
      for (int i = 0; i < 8; ++i) { a += bc[(seg * 8 + i) * 32 + k]; v[i] = a; }
#pragma unroll
      for (int i = 0; i < 8; ++i) bc[(seg * 8 + i) * 32 + k] = v[i];
    }
    __syncthreads();
    float off = 0.f;
    if (tid < 256) for (int s2 = 0; s2 < seg; ++s2) off += bc[(s2 * 8 + 7) * 32 + k];
    __syncthreads();
    if (tid < 256) {
#pragma unroll
      for (int i = 0; i < 8; ++i) bc[(seg * 8 + i) * 32 + k] = v[i] + off;
    }
  }
  __syncthreads();
}

__device__ void gla_passA_item(const Params& p, int l, int item, unsigned char* ldsraw) {
  float* qs = (float*)ldsraw; float* ks = qs + 2048; float* vs = ks + 2048; float* bc = vs + 4096;
  float* sc = bc + 2048; float* S0 = sc + 4096; float* gds = S0 + 2048;
  const int c = item & 63, bh = item >> 6, b = bh >> 2, h = bh & 3;
  gla_load(p, l, b, h, c, qs, ks, vs, bc, gds);
  const int tid = opaque_tid();
  float* kd = sc;
  for (int e = tid; e < 2048; e += NT) {
    const int k = e & 31;
    kd[e] = ks[e] * __expf(bc[63 * 32 + k] - bc[e]);
  }
  __syncthreads();
  float* gS = (float*)(p.ws + WS_GLAS) + (size_t)item * 2048;
  float* gD = (float*)(p.ws + WS_GLAD) + (size_t)item * 32;
  for (int e = tid; e < 2048; e += NT) {
    const int k = e >> 6, v = e & 63;
    float a = 0.f;
#pragma unroll 8
    for (int s = 0; s < 64; ++s) a += kd[s * 32 + k] * vs[s * 64 + v];
    gS[e] = a;
  }
  if (tid < 32) gD[tid] = __expf(bc[63 * 32 + tid]);
  __syncthreads();
}

__device__ void gla_passC_item(const Params& p, int l, int item, unsigned char* ldsraw) {
  float* qs = (float*)ldsraw; float* ks = qs + 2048; float* vs = ks + 2048; float* bc = vs + 4096;
  float* sc = bc + 2048; float* S0 = sc + 4096; float* gds = S0 + 2048;
  const int c = item & 63, bh = item >> 6, b = bh >> 2, h = bh & 3;
  gla_load(p, l, b, h, c, qs, ks, vs, bc, gds);
  const int tid = opaque_tid();
  const u16* proj = (const u16*)(p.ws + WS_PROJ);
  u16* mix = (u16*)(p.ws + WS_ABUF);
  const float* norm_g = p.in[17] + l * 256;
  const bool wide = __syncthreads_or(tid < 32 && bc[63 * 32 + tid] < -60.f) != 0;
  if (!wide) {
    float qv[4], kv[4];
#pragma unroll
    for (int i = 0; i < 4; ++i) {
      const int e = tid + NT * i, k = e & 31;
      const float m = bc[32 * 32 + k];
      qv[i] = qs[e] * __expf(bc[e] - m);
      kv[i] = ks[e] * __expf(m - bc[e]);
    }
    __syncthreads();
    float* QpT = S0;
    float* KpT = ks;
#pragma unroll
    for (int i = 0; i < 4; ++i) {
      const int e = tid + NT * i, t = e >> 5, k = e & 31;
      QpT[k * 64 + t] = qv[i];
      KpT[k * 64 + t] = kv[i];
    }
    __syncthreads();
    {
      const int t0 = (tid >> 4) * 2, s0 = (tid & 15) * 4;
      float a0[4] = {0.f, 0.f, 0.f, 0.f}, a1[4] = {0.f, 0.f, 0.f, 0.f};
#pragma unroll 8
      for (int k = 0; k < 32; ++k) {
        const float2 q2 = *(const float2*)(QpT + k * 64 + t0);
        const float4 k4 = *(const float4*)(KpT + k * 64 + s0);
        a0[0] += q2.x * k4.x; a0[1] += q2.x * k4.y; a0[2] += q2.x * k4.z; a0[3] += q2.x * k4.w;
        a1[0] += q2.y * k4.x; a1[1] += q2.y * k4.y; a1[2] += q2.y * k4.z; a1[3] += q2.y * k4.w;
      }
#pragma unroll
      for (int jx = 0; jx < 4; ++jx) {
        sc[t0 * 64 + s0 + jx] = (s0 + jx <= t0) ? a0[jx] : 0.f;
        sc[(t0 + 1) * 64 + s0 + jx] = (s0 + jx <= t0 + 1) ? a1[jx] : 0.f;
      }
    }
  } else {
    for (int e = tid; e < 4096; e += NT) {
      const int t = e >> 6, s = e & 63;
      float a = 0.f;
      if (s <= t) {
#pragma unroll 4
        for (int k = 0; k < 32; ++k) a += qs[t * 32 + k] * ks[s * 32 + k] * __expf(bc[t * 32 + k] - bc[s * 32 + k]);
      }
      sc[e] = a;
    }
  }
  __syncthreads();
  {
    const float* gS = (const float*)(p.ws + WS_GLAS) + (size_t)(bh * 64) * 2048;
    const float* gD = (const float*)(p.ws + WS_GLAD) + (size_t)(bh * 64) * 32;
    float a[4] = {0.f, 0.f, 0.f, 0.f};
#pragma unroll 8
    for (int cc = 0; cc < c; ++cc) {
#pragma unroll
      for (int i = 0; i < 4; ++i) {
        const int e = tid + NT * i;
        a[i] = a[i] * gD[cc * 32 + (e >> 6)] + gS[(size_t)cc * 2048 + e];
      }
    }
#pragma unroll
    for (int i = 0; i < 4; ++i) S0[tid + NT * i] = a[i];
  }
  for (int e = tid; e < 2048; e += NT) qs[e] *= __expf(bc[e]);
  __syncthreads();
  {
    const int t = tid >> 3, v0 = (tid & 7) * 8;
    float o[8];
#pragma unroll
    for (int i = 0; i < 8; ++i) o[i] = 0.f;
#pragma unroll 2
    for (int s = 0; s <= t; ++s) {
      const float w = sc[t * 64 + s];
#pragma unroll
      for (int i = 0; i < 8; ++i) o[i] += w * vs[s * 64 + v0 + i];
    }
#pragma unroll 2
    for (int k = 0; k < 32; ++k) {
      const float w = qs[t * 32 + k];
#pragma unroll
      for (int i = 0; i < 8; ++i) o[i] += w * S0[k * 64 + v0 + i];
    }
    float ss = 0.f;
#pragma unroll
    for (int i = 0; i < 8; ++i) ss += o[i] * o[i];
    ss += __shfl_xor(ss, 1, 64); ss += __shfl_xor(ss, 2, 64); ss += __shfl_xor(ss, 4, 64);
    const float rs = rsqrtf(ss * (1.f / 64.f) + EPS);
    const size_t tok = (size_t)b * T + c * 64 + t;
    u32 ow[4];
    float r2[8];
#pragma unroll
    for (int i = 0; i < 8; ++i) {
      const float g = bf2f(proj[tok * INW + GL0 + 528 + h * 64 + v0 + i]);
      const float sil = g / (1.f + __expf(-g));
      r2[i] = o[i] * rs * norm_g[h * 64 + v0 + i] * sil;
    }
#pragma unroll
    for (int i = 0; i < 4; ++i) ow[i] = pack2(r2[2 * i], r2[2 * i + 1]);
    *(uint4*)(mix + tok * D + 768 + h * 64 + v0) = make_uint4(ow[0], ow[1], ow[2], ow[3]);
  }
  __syncthreads();
}

__device__ void rwfinal_items(const Params& p, int l, unsigned char* ldsraw, int it_begin, int it_end, int it_step, bool stage_gup) {
  float* codes = (float*)ldsraw;
  u16* gul = (u16*)(ldsraw + 4096);
  const u16* proj = (const u16*)(p.ws + WS_PROJ);
  const u32* rwp = (const u32*)(p.ws + WS_RWP);
  const u16* vy = (const u16*)(p.ws + WS_VY);
  u16* mix = (u16*)(p.ws + WS_ABUF);
  const float* mu = p.in[4] + l * 1280;
  const float* g_up = p.in[9] + l * 64 * 384;
  const float* bon = (const float*)(p.ws + WS_CTRL + 65536);
  const float* gn_g = p.in[13] + l * 384;
  const float* gn_b = p.in[14] + l * 384;
  const int tid = opaque_tid();
  if (stage_gup) { for (int e = tid; e < 64 * 384; e += NT) gul[e] = f2bf(g_up[e]); }
  __syncthreads();
  for (int it = it_begin; it < it_end; it += it_step) {
    const int tok0 = it * 8;
    {
      const int tt = tid >> 6, j = tid & 63;
      const int tok = tok0 + tt;
      const int col = 1216 + j;
      const float pc = bf2f(proj[(size_t)tok * INW + RW0 + col]);
      const float pp = (tok % T == 0) ? 0.f : bf2f(proj[(size_t)(tok - 1) * INW + RW0 + col]);
      const float s = pc + (pp - pc) * mu[col];
      codes[tt * 64 + j] = 1.f / (1.f + __expf(-s));
    }
    __syncthreads();
    if (tid < 384) {
      const int c = tid;
      float ag[8], pv[8], py[8], pbn[8];
#pragma unroll
      for (int tt = 0; tt < 8; ++tt) {
        ag[tt] = 0.f;
        pv[tt] = bf2f(vy[(size_t)(tok0 + tt) * 384 + c]);
        py[tt] = bf2f(mix[(size_t)(tok0 + tt) * D + 384 + c]);
        pbn[tt] = bon[(size_t)(tok0 + tt) * 6 + (tid >> 6)];
      }
#pragma unroll 8
      for (int j = 0; j < 64; ++j) {
        const float gu = bf2f(gul[j * 384 + c]);
#pragma unroll
        for (int tt = 0; tt < 8; ++tt) ag[tt] += codes[tt * 64 + j] * gu;
      }
      const float gg = gn_g[c], gb = gn_b[c];
#pragma unroll
      for (int tt = 0; tt < 8; ++tt) {
        const float v = pv[tt], y = py[tt];
        const int tok = tok0 + tt;
        const float mean = wsum_u(y) * (1.f / 64.f);
        const float dv = y - mean;
        const float var = wsum_u(dv * dv) * (1.f / 64.f);
        const float yn = dv * rsqrtf(var + 64e-5f) * gg + gb;
        const float bonus = pbn[tt] * v;
        mix[(size_t)tok * D + 384 + c] = f2bf((yn + bonus) * ag[tt]);
      }
    }
    __syncthreads();
  }
}

__device__ __forceinline__ void fast_grid_barrier(u32* bw, u32 k, int G) {
  asm volatile("s_waitcnt vmcnt(0)" ::: "memory");
  __syncthreads();
  if (threadIdx.x == 0) {
    const u32 x = blockIdx.x & 7u, per = ((u32)G - x + 7u) >> 3;
    u32* A = bw + 16 * x; u32* W = bw + 16 * 8; u32* F = bw + 16 * (9 + x);
    __builtin_amdgcn_fence(__ATOMIC_RELEASE, "agent");
    asm volatile("s_waitcnt vmcnt(0)" ::: "memory");
    const u32 old = __hip_atomic_fetch_add(A, 1u, __ATOMIC_RELAXED, __HIP_MEMORY_SCOPE_AGENT);
    if (old + 1u == per * k) {
      const u32 oldw = __hip_atomic_fetch_add(W, 1u, __ATOMIC_RELAXED, __HIP_MEMORY_SCOPE_AGENT);
      if (oldw + 1u == 8u * k) {
        for (int i = 0; i < 8; ++i) __hip_atomic_store(bw + 16 * (9 + i), k, __ATOMIC_RELAXED, __HIP_MEMORY_SCOPE_AGENT);
      }
    }
    while (__hip_atomic_load(F, __ATOMIC_RELAXED, __HIP_MEMORY_SCOPE_AGENT) < k) __builtin_amdgcn_s_sleep(2);
    __builtin_amdgcn_fence(__ATOMIC_ACQUIRE, "agent");
    asm volatile("s_waitcnt vmcnt(0)" ::: "memory");
  }
  __syncthreads();
}

constexpr int LDS_BYTES = 147456;
#ifndef RES_TEST_ONLY
constexpr int N_SCAN_ITEMS = 96;
constexpr int N_ATT_ITEMS = 768;
constexpr int N_GLA_ITEMS = 1024;
constexpr int N_PREP_ITEMS = M / 16;
constexpr int N_FIN_ITEMS = M / 8;

template <bool COOP>
__global__ void __launch_bounds__(NT, 2) mega(Params p) {
  extern __shared__ __attribute__((aligned(16))) unsigned char lds[];
  int& s_item = *(int*)(lds + LDS_BYTES);
  const int G = gridDim.x;
  unsigned char* ws = p.ws;
  u32* ctr = (u32*)(ws + WS_CTRL);
  u16* abuf = (u16*)(ws + WS_ABUF);
  u16* cbuf = (u16*)(ws + WS_CBUF);
  u16* ffh = (u16*)(ws + WS_FFH);
  u16* proj = (u16*)(ws + WS_PROJ);
  u32 nbar = 0;
#pragma nounroll
  for (int ph = p.phase_lo; ph < p.phase_hi; ++ph) {
    const int l = (ph == 0) ? 0 : (ph - 1) / 9;
    const int kind = (ph == 0) ? 0 : 1 + (ph - 1) % 9;
    for (int rep = 0; rep < (((REPEAT_MASK >> kind) & 1) ? 2 : 1); ++rep) {
    if (rep) __syncthreads();
    switch (kind) {
      case 0:
        if (blockIdx.x == 0) { const int t0 = opaque_tid(); ctr[t0] = 0u; ctr[t0 + 512] = 0u; ctr[t0 + 1024] = 0u; ctr[t0 + 1536] = 0u; }
        prep_weights_layer(p, 0, (float*)lds, G);
        row_phase(p.in[0], nullptr, nullptr, nullptr, abuf, G);
        break;
      case 1:
        gemm_phase<EPI_BF16>(abuf, (const u16*)(ws + WS_WIN), proj, INW, D, INW, lds, G);
        break;
      case 2:
        break;
      case 3: {
#ifndef REP_SCAN
#define REP_SCAN 1
#endif
#ifndef REP_QUEUE
#define REP_QUEUE 1
#endif
        for (int r2 = 0; r2 < REP_SCAN; ++r2) {
        if (G > N_SCAN_ITEMS) {
          if ((int)blockIdx.x < N_SCAN_ITEMS) rwscan_item(p, l, blockIdx.x, lds);
        } else {
          for (int it = blockIdx.x; it < N_SCAN_ITEMS; it += G) rwscan_item(p, l, it, lds);
        }
        }
        bool gul_ready = false;
        for (int r2 = 0; r2 < REP_QUEUE; ++r2)
        for (;;) {
          __syncthreads();
          if (opaque_tid() == 0) s_item = (int)atomicAdd(&ctr[l + 2 * rep + 4 * r2], 1u);
          __syncthreads();
          int it = s_item;
          if (it >= N_PREP_ITEMS + N_ATT_ITEMS + 2 * N_GLA_ITEMS + N_FIN_ITEMS) break;
          if (it >= N_PREP_ITEMS + N_ATT_ITEMS + 2 * N_GLA_ITEMS) {
            const int fi = it - (N_PREP_ITEMS + N_ATT_ITEMS + 2 * N_GLA_ITEMS);
            const int within = fi & 7, rr = fi >> 3, bb = rr & 3, tb = rr >> 2;
            if (opaque_tid() == 0) {
              const u32* sd = ctr + 1024 + l * 256 + bb * 64 + tb;
              while (__hip_atomic_load(sd, __ATOMIC_RELAXED, __HIP_MEMORY_SCOPE_AGENT) < 24u) __builtin_amdgcn_s_sleep(100);
              __builtin_amdgcn_fence(__ATOMIC_ACQUIRE, "agent");
              asm volatile("s_waitcnt vmcnt(0)" ::: "memory");
            }
            __syncthreads();
            const int fit = (bb * T + tb * 64) / 8 + within;
            rwfinal_items(p, l, lds, fit, fit + 1, 1, !gul_ready);
            gul_ready = true;
            continue;
          }
          gul_ready = false;
          if (it < N_PREP_ITEMS) {
            const int within = it & 3, rr = it >> 2, bb = rr & 3, tb = rr >> 2;
            const int pit = (bb * T + tb * 64) / 4 + within * 4;
            rwprep_items(p, l, lds, pit, pit + 4, 1);
            asm volatile("s_waitcnt vmcnt(0)" ::: "memory");
            __syncthreads();
            if (opaque_tid() == 0) {
              __builtin_amdgcn_fence(__ATOMIC_RELEASE, "agent");
              asm volatile("s_waitcnt vmcnt(0)" ::: "memory");
              __hip_atomic_fetch_add(ctr + 512 + l * 256 + bb * 64 + tb, 1u, __ATOMIC_RELAXED, __HIP_MEMORY_SCOPE_AGENT);
            }
            continue;
          }
          it -= N_PREP_ITEMS;
          u32* glaA_done = ctr + 40 + l;
          if (it < N_GLA_ITEMS) {
            gla_passA_item(p, l, it, lds);
            asm volatile("s_waitcnt vmcnt(0)" ::: "memory");
            __syncthreads();
            if (opaque_tid() == 0) {
              __builtin_amdgcn_fence(__ATOMIC_RELEASE, "agent");
              asm volatile("s_waitcnt vmcnt(0)" ::: "memory");
              __hip_atomic_fetch_add(glaA_done, 1u, __ATOMIC_RELAXED, __HIP_MEMORY_SCOPE_AGENT);
            }
          } else if (it < N_GLA_ITEMS + N_ATT_ITEMS) {
            sbattn_item(p, l, it - N_GLA_ITEMS, lds);
          } else {
            if (opaque_tid() == 0) {
              while (__hip_atomic_load(glaA_done, __ATOMIC_RELAXED, __HIP_MEMORY_SCOPE_AGENT) < (u32)N_GLA_ITEMS) __builtin_amdgcn_s_sleep(8);
              __builtin_amdgcn_fence(__ATOMIC_ACQUIRE, "agent");
              asm volatile("s_waitcnt vmcnt(0)" ::: "memory");
            }
            __syncthreads();
            gla_passC_item(p, l, it - N_GLA_ITEMS - N_ATT_ITEMS, lds);
          }
        }
      } break;
      case 4:
        break;
      case 5:
        gemm_phase<EPI_BF16>(abuf, (const u16*)(ws + WS_WOUT), cbuf, D, D, D, lds, G);
        break;
      case 6:
        row_phase(l == 0 ? p.in[0] : p.out, cbuf, p.in[19] + l * D, p.out, abuf, G);
        break;
      case 7:
        gemm_phase<EPI_RELU2>(abuf, (const u16*)(ws + WS_WF1), ffh, DFF, D, DFF, lds, G);
        break;
      case 8:
        gemm_phase<EPI_BF16>(ffh, (const u16*)(ws + WS_WF2), cbuf, D, DFF, D, lds, G);
        break;
      default:
        row_phase(p.out, cbuf, p.in[23] + l * D, p.out, l == 0 ? abuf : nullptr, G);
        if (l == 0) prep_weights_layer(p, 1, (float*)lds, G);
        break;
    }
    }
    if (COOP) {
      if (ph + 1 < p.phase_hi && kind != 2 && kind != 4) {
        if (ph == 0) cg::this_grid().sync();
        else fast_grid_barrier(ctr + 64, ++nbar, G);
      }
    }
  }
}
constexpr int N_PHASES = 19;

extern "C" void kernel_launch(void* const* d_in, const int* in_sizes, int n_in, void* d_out, int out_size,
                              void* d_ws, size_t ws_size, hipStream_t stream) {
  Params p{};
  for (int i = 0; i < 24; ++i) p.in[i] = (const float*)d_in[i];
  p.out = (float*)d_out;
  p.ws = (unsigned char*)d_ws;
#if MULTI_LAUNCH
  for (int ph = 0; ph < N_PHASES; ++ph) {
    p.phase_lo = ph; p.phase_hi = ph + 1;
    hipLaunchKernelGGL(mega<false>, dim3(512), dim3(NT), LDS_BYTES + 16, stream, p);
  }
#else
  static int grid_blocks = 0;
  if (!grid_blocks) {
    int dev = 0, cus = 0, per_cu = 0;
    hipGetDevice(&dev);
    hipDeviceGetAttribute(&cus, hipDeviceAttributeMultiprocessorCount, dev);
    (void)hipFuncSetAttribute((const void*)mega<true>, hipFuncAttributeMaxDynamicSharedMemorySize, LDS_BYTES + 16);
    hipOccupancyMaxActiveBlocksPerMultiprocessor(&per_cu, mega<true>, NT, LDS_BYTES + 16);
    if (per_cu > 2) per_cu = 2;
    if (per_cu < 1) per_cu = 1;
    grid_blocks = cus * per_cu;
  }
  p.phase_lo = 0; p.phase_hi = N_PHASES;
  void* args[] = {&p};
  hipError_t e = hipLaunchCooperativeKernel((void*)mega<true>, dim3(grid_blocks), dim3(NT), args, LDS_BYTES + 16, stream);
  if (e != hipSuccess) fprintf(stderr, "cooperative launch failed: %s (grid %d)\n", hipGetErrorString(e), grid_blocks);
#endif
}
#endif
```
